# Optimizing an MI355X kernel written in HIP

```python
import math
import jax, jax.numpy as jnp
from jax import lax
import numpy as np

D_MODEL = 1024
BATCH = 16
SEQ = 4096
DEPTH = 4

NORM_EPS = 1e-6
N_BRANCHES = 4
BRANCH_WIDTH = 512
D_FF = 4 * D_MODEL
Q_BLOCK = 128

DN_HEADS = 4
DN_HEAD_DIM = 128
DN_CONV = 4
DN_CHUNK = 64

MLA_HEADS = 4
MLA_Q_RANK = 256
MLA_KV_RANK = 128
MLA_NOPE = 128
MLA_ROPE = 64
MLA_V = 128
MLA_QK_DIM = MLA_NOPE + MLA_ROPE
ROPE_THETA = 10000.0

SG_GROUPS = 4
SG_GROUP_DIM = 128
SG_CHUNK = 128

FOX_HEADS = 4
FOX_HEAD_DIM = 128

IN_SPLITS = (
    3 * DN_HEADS * DN_HEAD_DIM,
    DN_HEADS * DN_HEAD_DIM,
    DN_HEADS,
    DN_HEADS,
    MLA_Q_RANK,
    MLA_KV_RANK,
    MLA_ROPE,
    SG_GROUPS * SG_GROUP_DIM,
    SG_GROUPS * SG_GROUP_DIM,
    3 * FOX_HEADS * FOX_HEAD_DIM,
    FOX_HEADS,
    N_BRANCHES * D_MODEL,
)
D_IN = sum(IN_SPLITS)

kernel_name = "hybrid_gdn_mla_sgmlp_fox_trunk"


def rms_norm(x, g, eps=NORM_EPS):
    xf = x.astype(jnp.float32)
    y = xf * lax.rsqrt(jnp.mean(xf * xf, axis=-1, keepdims=True) + eps)
    return (y * g.astype(jnp.float32)).astype(x.dtype)


def l2_norm(x, eps=NORM_EPS):
    return x * lax.rsqrt(jnp.sum(x * x, axis=-1, keepdims=True) + eps)


def causal_depthwise_conv(x, w):
    K = w.shape[0]
    S = x.shape[1]
    xp = jnp.pad(x, ((0, 0), (K - 1, 0), (0, 0)))
    out = xp[:, 0:S, :] * w[0]
    for k in range(1, K):
        out = out + xp[:, k:k + S, :] * w[k]
    return out


def rope_tables(positions):
    inv_freq = ROPE_THETA ** (-jnp.arange(0, MLA_ROPE, 2, dtype=jnp.float32) / MLA_ROPE)
    ang = positions.astype(jnp.float32)[..., None] * inv_freq
    return jnp.cos(ang)[:, :, None, :], jnp.sin(ang)[:, :, None, :]


def apply_rope(x, cos, sin):
    xf = x.astype(jnp.float32)
    x1, x2 = jnp.split(xf, 2, axis=-1)
    return jnp.concatenate([x1 * cos - x2 * sin, x2 * cos + x1 * sin], axis=-1).astype(x.dtype)


def block_causal_attention(q, k, v, log_decay=None):
    B, H, S, dk = q.shape
    nb = S // Q_BLOCK
    scale = dk ** -0.5
    k_pos = jnp.arange(S)

    def to_blocks(a):
        return jnp.moveaxis(a.reshape(B, H, nb, Q_BLOCK, *a.shape[3:]), 2, 0)

    xs = {"idx": jnp.arange(nb), "q": to_blocks(q)}
    if log_decay is not None:
        xs["d"] = to_blocks(log_decay)

    def attend(blk):
        q_pos = blk["idx"] * Q_BLOCK + jnp.arange(Q_BLOCK)
        s = jnp.einsum("bhqd,bhkd->bhqk", blk["q"], k).astype(jnp.float32) * scale
        if log_decay is not None:
            s = s + (blk["d"][..., :, None] - log_decay[..., None, :])
        s = jnp.where(k_pos[None, :] <= q_pos[:, None], s, -jnp.inf)
        p = jax.nn.softmax(s, axis=-1).astype(v.dtype)
        return jnp.einsum("bhqk,bhkd->bhqd", p, v)

    out = lax.map(attend, xs)
    return jnp.moveaxis(out, 0, 2).reshape(B, H, S, v.shape[-1])


def gated_deltanet(qkv, z, a_logit, b_logit, conv_w, a_log, dt_bias, out_g):
    B, S, _ = qkv.shape
    H, dk, C = DN_HEADS, DN_HEAD_DIM, DN_CHUNK
    N = S // C
    qkv = jax.nn.silu(causal_depthwise_conv(qkv, conv_w)).astype(jnp.float32)
    q, k, v = jnp.split(qkv, 3, axis=-1)

    def heads(t):
        return t.reshape(B, S, H, dk).transpose(0, 2, 1, 3)

    q = l2_norm(heads(q)) * dk ** -0.5
    k = l2_norm(heads(k))
    v = heads(v)
    beta = jax.nn.sigmoid(b_logit.astype(jnp.float32)).transpose(0, 2, 1)
    g = (-jnp.exp(a_log.astype(jnp.float32))
         * jax.nn.softplus(a_logit.astype(jnp.float32) + dt_bias.astype(jnp.float32))).transpose(0, 2, 1)

    def chunk(t):
        return t.reshape(B, H, N, C, *t.shape[3:])

    q, k, v, beta, g = chunk(q), chunk(k), chunk(v), chunk(beta), chunk(g)
    gc = jnp.cumsum(g, axis=-1)
    tril = jnp.tril(jnp.ones((C, C), dtype=bool))
    strict = jnp.tril(jnp.ones((C, C), dtype=bool), -1)
    diff = gc[..., :, None] - gc[..., None, :]
    decay = jnp.where(tril, jnp.exp(jnp.where(tril, diff, 0.0)), 0.0)

    kb = k * beta[..., None]
    lower = jnp.where(strict, jnp.einsum("bhnid,bhnjd->bhnij", kb, k) * decay, 0.0)
    rhs = jnp.concatenate([v * beta[..., None], kb * jnp.exp(gc)[..., None]], axis=-1)
    sol = lax.linalg.triangular_solve(lower + jnp.eye(C, dtype=jnp.float32), rhs,
                                      left_side=True, lower=True, unit_diagonal=True)
    u, w = jnp.split(sol, 2, axis=-1)

    a_qk = jnp.einsum("bhnid,bhnjd->bhnij", q, k) * decay
    q_dec = q * jnp.exp(gc)[..., None]
    k_dec = k * jnp.exp(gc[..., -1:] - gc)[..., None]
    g_last = jnp.exp(gc[..., -1])

    def step(state, xs):
        q_i, k_i, u_i, w_i, a_i, gl_i = xs
        v_new = u_i - jnp.einsum("bhcd,bhde->bhce", w_i, state)
        o_i = jnp.einsum("bhcd,bhde->bhce", q_i, state) + jnp.einsum("bhij,bhje->bhie", a_i, v_new)
        state = state * gl_i[..., None, None] + jnp.einsum("bhcd,bhce->bhde", k_i, v_new)
        return state, o_i

    xs = tuple(jnp.moveaxis(t, 2, 0) for t in (q_dec, k_dec, u, w, a_qk, g_last))
    _, o = lax.scan(step, jnp.zeros((B, H, dk, dk), jnp.float32), xs)
    o = jnp.moveaxis(o, 0, 2).reshape(B, H, S, dk)
    o = rms_norm(o, out_g).transpose(0, 2, 1, 3).reshape(B, S, H * dk)
    return (o * jax.nn.silu(z.astype(jnp.float32))).astype(z.dtype)


def latent_attention(c_q, c_kv, k_rope, positions, q_norm_g, kv_norm_g, w_uq, w_ukv, qk_q_g, qk_k_g):
    B, S, _ = c_q.shape
    H = MLA_HEADS
    q = (rms_norm(c_q, q_norm_g) @ w_uq).reshape(B, S, H, MLA_QK_DIM)
    kv = (rms_norm(c_kv, kv_norm_g) @ w_ukv).reshape(B, S, H, MLA_NOPE + MLA_V)
    k_nope, v = jnp.split(kv, [MLA_NOPE], axis=-1)
    k = jnp.concatenate([k_nope, jnp.broadcast_to(k_rope[:, :, None, :], (B, S, H, MLA_ROPE))], axis=-1)
    q = rms_norm(q, qk_q_g)
    k = rms_norm(k, qk_k_g)
    cos, sin = rope_tables(positions)
    q = jnp.concatenate([q[..., :MLA_NOPE], apply_rope(q[..., MLA_NOPE:], cos, sin)], axis=-1)
    k = jnp.concatenate([k[..., :MLA_NOPE], apply_rope(k[..., MLA_NOPE:], cos, sin)], axis=-1)
    o = block_causal_attention(q.transpose(0, 2, 1, 3), k.transpose(0, 2, 1, 3), v.transpose(0, 2, 1, 3))
    return o.transpose(0, 2, 1, 3).reshape(B, S, H * MLA_V)


def spatial_gating(u, v, norm_g, w_s, b_s):
    B, S, _ = u.shape
    G, Cg, T = SG_GROUPS, SG_GROUP_DIM, SG_CHUNK
    N = S // T
    u = jax.nn.gelu(u)
    v = rms_norm(jax.nn.gelu(v).reshape(B, S, G, Cg), norm_g).reshape(B, N, T, G, Cg)
    w_causal = jnp.where(jnp.tril(jnp.ones((T, T), dtype=bool)), w_s, 0.0)
    mixed = jnp.einsum("gts,bnsgc->bntgc", w_causal, v) + b_s.T[None, None, :, :, None]
    return u * mixed.reshape(B, S, G * Cg)


def forgetting_attention(qkv, f_logit, f_bias, q_g, k_g):
    B, S, _ = qkv.shape
    H, dh = FOX_HEADS, FOX_HEAD_DIM
    q, k, v = jnp.split(qkv, 3, axis=-1)

    def heads(t):
        return t.reshape(B, S, H, dh).transpose(0, 2, 1, 3)

    q = rms_norm(heads(q), q_g)
    k = rms_norm(heads(k), k_g)
    log_f = jax.nn.log_sigmoid(f_logit.astype(jnp.float32) + f_bias.astype(jnp.float32))
    cum = jnp.cumsum(log_f, axis=1).transpose(0, 2, 1)
    o = block_causal_attention(q, k, heads(v), cum)
    return o.transpose(0, 2, 1, 3).reshape(B, S, H * dh)


def setup_inputs(seed: int = 0) -> dict:
    key = jax.random.key(seed)
    ks = jax.random.split(key, 26)
    L = DEPTH
    f32 = jnp.float32

    def nrm(k, shape, fan_in):
        return jax.random.normal(k, shape, f32) * fan_in ** -0.5

    def gain(k, shape):
        return 1.0 + 0.1 * jax.random.normal(k, shape, f32)

    dt = jnp.exp(jax.random.uniform(ks[4], (L, DN_HEADS), f32, math.log(1e-3), math.log(1e-1)))
    return {
        "x": jax.random.normal(ks[0], (BATCH, SEQ, D_MODEL), f32),
        "positions": jnp.broadcast_to(jnp.arange(SEQ, dtype=jnp.int32)[None, :], (BATCH, SEQ)),
        "norm1_g": gain(ks[1], (L, D_MODEL)),
        "w_in": nrm(ks[2], (L, D_MODEL, D_IN), D_MODEL),
        "dn_conv_w": nrm(ks[3], (L, DN_CONV, 3 * DN_HEADS * DN_HEAD_DIM), DN_CONV),
        "dn_a_log": jnp.log(jax.random.uniform(ks[5], (L, DN_HEADS), f32, 1.0, 16.0)),
        "dn_dt_bias": dt + jnp.log(-jnp.expm1(-dt)),
        "dn_out_norm_g": gain(ks[6], (L, DN_HEAD_DIM)),
        "mla_q_norm_g": gain(ks[7], (L, MLA_Q_RANK)),
        "mla_kv_norm_g": gain(ks[8], (L, MLA_KV_RANK)),
        "mla_w_uq": nrm(ks[9], (L, MLA_Q_RANK, MLA_HEADS * MLA_QK_DIM), MLA_Q_RANK),
        "mla_w_ukv": nrm(ks[10], (L, MLA_KV_RANK, MLA_HEADS * (MLA_NOPE + MLA_V)), MLA_KV_RANK),
        "mla_qk_q_g": gain(ks[11], (L, MLA_QK_DIM)),
        "mla_qk_k_g": gain(ks[12], (L, MLA_QK_DIM)),
        "sg_v_norm_g": gain(ks[13], (L, SG_GROUPS, SG_GROUP_DIM)),
        "sg_w_s": nrm(ks[14], (L, SG_GROUPS, SG_CHUNK, SG_CHUNK), SG_CHUNK),
        "sg_b_s": gain(ks[15], (L, SG_GROUPS, SG_CHUNK)),
        "fox_q_norm_g": gain(ks[16], (L, FOX_HEAD_DIM)),
        "fox_k_norm_g": gain(ks[17], (L, FOX_HEAD_DIM)),
        "fox_f_bias": 4.0 + jax.random.normal(ks[18], (L, FOX_HEADS), f32),
        "w_branch": nrm(ks[19], (L, N_BRANCHES, BRANCH_WIDTH, D_MODEL), BRANCH_WIDTH),
        "w_out": nrm(ks[20], (L, D_MODEL, D_MODEL), D_MODEL),
        "norm2_g": gain(ks[21], (L, D_MODEL)),
        "w_ff1": nrm(ks[22], (L, D_MODEL, D_FF), D_MODEL),
        "w_ff2": nrm(ks[23], (L, D_FF, D_MODEL), D_FF),
    }


def reference(x, positions, norm1_g, w_in, dn_conv_w, dn_a_log, dn_dt_bias, dn_out_norm_g,
              mla_q_norm_g, mla_kv_norm_g, mla_w_uq, mla_w_ukv, mla_qk_q_g, mla_qk_k_g,
              sg_v_norm_g, sg_w_s, sg_b_s, fox_q_norm_g, fox_k_norm_g, fox_f_bias,
              w_branch, w_out, norm2_g, w_ff1, w_ff2):
    B, S, _ = x.shape
    split_points = np.cumsum(IN_SPLITS)[:-1]
    for l in range(DEPTH):
        h = rms_norm(x, norm1_g[l])
        proj = h @ w_in[l]
        (dn_qkv, dn_z, dn_a, dn_b, mla_cq, mla_ckv, mla_kr,
         sg_u, sg_v, fox_qkv, fox_f, gate_logits) = jnp.split(proj, split_points, axis=-1)

        o_a = gated_deltanet(dn_qkv, dn_z, dn_a, dn_b, dn_conv_w[l], dn_a_log[l],
                             dn_dt_bias[l], dn_out_norm_g[l])
        o_b = latent_attention(mla_cq, mla_ckv, mla_kr, positions, mla_q_norm_g[l], mla_kv_norm_g[l],
                               mla_w_uq[l], mla_w_ukv[l], mla_qk_q_g[l], mla_qk_k_g[l])
        o_c = spatial_gating(sg_u, sg_v, sg_v_norm_g[l], sg_w_s[l], sg_b_s[l])
        o_d = forgetting_attention(fox_qkv, fox_f, fox_f_bias[l], fox_q_norm_g[l], fox_k_norm_g[l])

        branches = jnp.stack([o_a.astype(x.dtype), o_b.astype(x.dtype),
                              o_c.astype(x.dtype), o_d.astype(x.dtype)], axis=2)
        projected = jnp.einsum("bsiw,iwd->bsid", branches, w_branch[l])
        gates = jax.nn.sigmoid(gate_logits.reshape(B, S, N_BRANCHES, D_MODEL))
        merged = jnp.sum(gates * projected, axis=2)
        x = x + merged @ w_out[l]

        h2 = rms_norm(x, norm2_g[l])
        x = x + jnp.square(jax.nn.relu(h2 @ w_ff1[l])) @ w_ff2[l]
    return x
```

```cpp
#include <hip/hip_runtime.h>
#include <hip/hip_cooperative_groups.h>
#include <cstdio>
namespace cg = cooperative_groups;

#define DI __device__ __forceinline__
#define LAS __attribute__((address_space(3)))
typedef unsigned short bf16_t;
typedef short bf16x8 __attribute__((ext_vector_type(8)));
typedef short s16x4 __attribute__((ext_vector_type(4)));
typedef float f32x4 __attribute__((ext_vector_type(4)));
typedef float f32x16 __attribute__((ext_vector_type(16)));
typedef unsigned u32x4 __attribute__((ext_vector_type(4)));
typedef unsigned u32x2 __attribute__((ext_vector_type(2)));

constexpr int TS = 32768, SEQ = 4096, PLD = 5056, NTHR = 512;
constexpr int LDS_BYTES = 160 * 1024;
constexpr int N_STEPS = 22, N_PHASES = 4 * N_STEPS;
constexpr float NEPS = 1e-6f;
constexpr float LOG2E = 1.4426950408889634f;

constexpr size_t SZ_CTL = 4096;
constexpr size_t OFF_WT_IN = SZ_CTL;
constexpr size_t OFF_WT_GATE = OFF_WT_IN + (size_t)5120 * 1024 * 2;
constexpr size_t OFF_WT_MLA = OFF_WT_GATE + (size_t)4096 * 1024 * 2;
constexpr size_t OFF_WT_BR = OFF_WT_MLA + (size_t)1792 * 384 * 2;
constexpr size_t OFF_WT_OUT = OFF_WT_BR + (size_t)4096 * 512 * 2;
constexpr size_t OFF_WT_FF1 = OFF_WT_OUT + (size_t)1024 * 1024 * 2;
constexpr size_t OFF_WT_FF2 = OFF_WT_FF1 + (size_t)4096 * 1024 * 2;
constexpr size_t OFF_SGW = OFF_WT_FF2 + (size_t)1024 * 4096 * 2;
constexpr size_t OFF_HBUF = OFF_SGW + (size_t)4 * 128 * 128 * 2;
constexpr size_t OFF_HB = OFF_HBUF + (size_t)65536 * 1024 * 2;
constexpr size_t OFF_PROJ = OFF_HB;
constexpr size_t OFF_SMALL = OFF_PROJ + (size_t)TS * PLD * 2;
constexpr size_t OFF_MLAA = OFF_SMALL + (size_t)TS * 16 * 4;
constexpr size_t OFF_MLARAW = OFF_MLAA + (size_t)TS * 384 * 2;
constexpr size_t OFF_MLAQ = OFF_MLARAW + (size_t)TS * 1792 * 2;
constexpr size_t OFF_MLAK = OFF_MLAQ + (size_t)TS * 768 * 2;
constexpr size_t OFF_MLAVT = OFF_MLAK + (size_t)TS * 768 * 2;
constexpr size_t OFF_FOXVT = OFF_MLAVT + (size_t)TS * 512 * 2;
constexpr size_t OFF_FOXCUM = OFF_FOXVT + (size_t)TS * 512 * 2;
constexpr size_t OFF_DNP = OFF_FOXCUM + (size_t)TS * 4 * 4;
constexpr int NCH = 2048;
constexpr size_t DNP_MAT = (size_t)NCH * 8192 * 2;
constexpr size_t OFF_DN_QDEC = OFF_DNP, OFF_DN_NEGW = OFF_DNP + DNP_MAT, OFF_DN_U = OFF_DNP + 2 * DNP_MAT, OFF_DN_KDT = OFF_DNP + 3 * DNP_MAT;
constexpr size_t OFF_DN_AQK = OFF_DNP + 4 * DNP_MAT;
constexpr size_t OFF_DN_GLAST = OFF_DN_AQK + (size_t)NCH * 4096 * 2;
constexpr size_t OFF_END = OFF_DN_GLAST + (size_t)NCH * 4;
constexpr size_t OFF_OBUF = OFF_MLAA;
constexpr size_t OFF_P = OFF_PROJ;
constexpr size_t OFF_MERGED = OFF_DNP;
constexpr size_t OFF_HID = OFF_HB;
static_assert((size_t)TS * 2048 * 2 <= OFF_MLAQ - OFF_MLAA, "obuf overlay");
static_assert((size_t)65536 * 4096 * 2 <= OFF_END - OFF_HB, "hid overlay");

struct Params { const float* in[25]; float* out; unsigned char* ws; int ph_lo, ph_hi; };

DI float bf2f(bf16_t b) { return __uint_as_float(((unsigned)b) << 16); }
DI bf16_t f2bf(float f) { unsigned u = __float_as_uint(f); u += 0x7fffu + ((u >> 16) & 1u); return (bf16_t)(u >> 16); }
DI unsigned pk2(float lo, float hi) { return (unsigned)f2bf(lo) | ((unsigned)f2bf(hi) << 16); }
DI float wave_sum(float v) { for (int o = 32; o; o >>= 1) v += __shfl_xor(v, o); return v; }
DI float sigmoidf_(float x) { return 1.f / (1.f + __expf(-x)); }
DI float siluf_(float x) { return x / (1.f + __expf(-x)); }
DI float geluf_(float x) { const float u = 0.7978845608028654f * (x + 0.044715f * x * x * x); return 0.5f * x * (1.f + tanhf(u)); }
DI int crow(int i, int h) { return (i & 3) + 8 * (i >> 2) + 4 * h; }
#define MFMA32(a, b, c) __builtin_amdgcn_mfma_f32_32x32x16_bf16((a), (b), (c), 0, 0, 0)
DI bf16x8 pack8(const f32x16& x, int s) {
    u32x4 p;
    p[0] = pk2(x[8 * s + 0], x[8 * s + 1]); p[1] = pk2(x[8 * s + 2], x[8 * s + 3]);
    p[2] = pk2(x[8 * s + 4], x[8 * s + 5]); p[3] = pk2(x[8 * s + 6], x[8 * s + 7]);
    return __builtin_bit_cast(bf16x8, p);
}
DI bf16x8 ld_perm(const bf16_t* p) {
    const s16x4 lo = *(const s16x4*)p, hi = *(const s16x4*)(p + 8);
    return __builtin_shufflevector(lo, hi, 0, 1, 2, 3, 4, 5, 6, 7);
}

namespace pg8 {
constexpr int BM = 256, BK = 64, HALF = 128, HTB = HALF * BK * 2, NXCD = 8, WGM = 8;
DI int lds_byte(int r, int c) { const int st = (r >> 4) * 2 + (c >> 5), rr = r & 15, cc = c & 31, ob = rr * 64 + cc * 2; return st * 1024 + (ob ^ (((ob >> 9) & 1) << 5)); }
DI void stage_rc(int b, int& R, int& C) { const int st = b / 1024, sb = b % 1024, swz = sb ^ (((sb >> 9) & 1) << 5); R = (st >> 1) * 16 + swz / 64; C = (st & 1) * 32 + (swz % 64) / 2; }
DI int perm32(int rho) { const int n = rho >> 4, i = rho & 15; return 8 * (i >> 2) + 4 * n + (i & 3); }
struct Unit { int pm, pn, z; };
struct Gemm { const bf16_t* A; const bf16_t* Bt; int lda, ldb, K, nM, nN, nZ; long zA, zB; };
struct Order {
    int nM, nN, nwg, total, G, c;
    DI void init(const Gemm& g) { nM = g.nM; nN = g.nN; nwg = nM * nN; total = nwg * g.nZ; G = gridDim.x; c = blockIdx.x; }
    DI bool next(int i, Unit& u) const {
        const long L = (long)i * G + c; if (L >= total) return false;
        u.z = (int)(L / nwg); int wgid = (int)(L % nwg);
        { const int q = nwg / NXCD, r = nwg % NXCD, xcd = wgid % NXCD, off = wgid / NXCD; wgid = (xcd < r ? xcd * (q + 1) : r * (q + 1) + (xcd - r) * q) + off; }
        const int nig = WGM * nN, gid = wgid / nig, fm = gid * WGM, gsz = (nM - fm) < WGM ? (nM - fm) : WGM;
        u.pm = fm + ((wgid % nig) % gsz); u.pn = (wgid % nig) / gsz; return true;
    }
};

template <class Epi>
DI void gemm_phase(LAS unsigned char* lds, const Gemm g, const Epi& E, const int tid) {
    const int wid = __builtin_amdgcn_readfirstlane(tid >> 6), lane = tid & 63, wr = wid >> 2, wc = wid & 3, fr = lane & 15, fq = lane >> 4;
    const int K = g.K, nt = K / BK;
    Order S; S.init(g);
    unsigned voffA[2], voffB[2];
#pragma unroll
    for (int i = 0; i < 2; ++i) { int R, C; stage_rc(tid * 16 + i * 8192, R, C); const int Rb = Epi::PERM ? ((R & ~31) + perm32(R & 31)) : R;
        voffA[i] = (unsigned)(R * g.lda + C) * 2u; voffB[i] = (unsigned)(Rb * g.ldb + C) * 2u; }
    const size_t kstep = (size_t)(BK * 2);
    const size_t hstepA = (size_t)HALF * g.lda * 2, hstepB = (size_t)HALF * g.ldb * 2;
    const unsigned ldsw = (unsigned)wid * 1024u;
    const int aoff = lds_byte(wr * 64 + fr, fq * 8), boff = lds_byte(wc * 32 + fr, fq * 8);
#define PG8_SA(b, h) (((b) * 2 + (h)) * HTB)
#define PG8_SB(b, h) ((4 + (b) * 2 + (h)) * HTB)
#define PG8_STAGE(bufoff, gbase, voff) do { _Pragma("unroll") for (int _i = 0; _i < 2; ++_i) \
        __builtin_amdgcn_global_load_lds((const unsigned*)((const char*)(gbase) + (voff)[_i]), (LAS unsigned*)(lds + (bufoff) + ldsw + _i * 8192), 16, 0, 0); } while (0)
#define PG8_LDA(dst, b, h) do { _Pragma("unroll") for (int m = 0; m < 4; ++m) _Pragma("unroll") for (int k = 0; k < 2; ++k) dst[m][k] = *(const LAS bf16x8*)(lds + PG8_SA(b, h) + aoff + m * 2048 + k * 1024); } while (0)
#define PG8_LDB(dst, b, h) do { _Pragma("unroll") for (int n = 0; n < 2; ++n) _Pragma("unroll") for (int k = 0; k < 2; ++k) dst[n][k] = *(const LAS bf16x8*)(lds + PG8_SB(b, h) + boff + n * 2048 + k * 1024); } while (0)
#define PG8_MMA(ai, bj, At, Bt) do { __builtin_amdgcn_s_setprio(1); _Pragma("unroll") for (int m = 0; m < 4; ++m) _Pragma("unroll") for (int n = 0; n < 2; ++n) _Pragma("unroll") for (int k = 0; k < 2; ++k) \
        acc[ai][bj][m][n] = __builtin_amdgcn_mfma_f32_16x16x32_bf16(Bt[n][k], At[m][k], acc[ai][bj][m][n], 0, 0, 0); __builtin_amdgcn_s_setprio(0); } while (0)
#define PG8_WAIT_V(n) asm volatile("s_waitcnt vmcnt(" #n ")" ::: "memory")
#define PG8_WAIT_L(n) asm volatile("s_waitcnt lgkmcnt(" #n ")" ::: "memory")
#define PG8_BAR __builtin_amdgcn_s_barrier()
#define PG8_SCHED __builtin_amdgcn_sched_barrier(0)
    Unit cur, nxt; int ui = 0;
    if (!S.next(0, cur)) return;
    f32x4 acc[2][2][4][2];
#pragma unroll
    for (int a = 0; a < 2; ++a)
#pragma unroll
        for (int b = 0; b < 2; ++b)
#pragma unroll
            for (int m = 0; m < 4; ++m)
#pragma unroll
                for (int n = 0; n < 2; ++n) acc[a][b][m][n] = (f32x4){0.f, 0.f, 0.f, 0.f};
    bf16x8 At[4][2], B0[2][2], B1[2][2];
    const char* cA = (const char*)g.A + (size_t)cur.z * g.zA * 2 + (size_t)cur.pm * 2 * hstepA;
    const char* cB = (const char*)g.Bt + (size_t)cur.z * g.zB * 2 + (size_t)cur.pn * 2 * hstepB;
    PG8_STAGE(PG8_SB(0, 0), cB, voffB); PG8_STAGE(PG8_SA(0, 0), cA, voffA); PG8_STAGE(PG8_SB(0, 1), cB + hstepB, voffB); PG8_STAGE(PG8_SA(0, 1), cA + hstepA, voffA);
    if (wr == 1) PG8_BAR;
    PG8_WAIT_V(4); PG8_BAR;
    PG8_STAGE(PG8_SB(1, 0), cB + kstep, voffB); PG8_STAGE(PG8_SA(1, 0), cA + kstep, voffA); PG8_STAGE(PG8_SB(1, 1), cB + hstepB + kstep, voffB);
    PG8_WAIT_V(6); PG8_BAR;
    for (;;) {
        const bool has_next = S.next(ui + 1, nxt);
        const char* nA = has_next ? (const char*)g.A + (size_t)nxt.z * g.zA * 2 + (size_t)nxt.pm * 2 * hstepA : cA;
        const char* nB = has_next ? (const char*)g.Bt + (size_t)nxt.z * g.zB * 2 + (size_t)nxt.pn * 2 * hstepB : cB;
#pragma clang loop unroll(disable)
        for (int t = 0; t < nt; t += 2) {
            const bool last = (t == nt - 2);
            const char* a1 = cA + (size_t)(t + 1) * kstep;
            const char* a2 = last ? nA : cA + (size_t)(t + 2) * kstep; const char* b2 = last ? nB : cB + (size_t)(t + 2) * kstep;
            const char* a3 = a2 + kstep; const char* b3 = b2 + kstep;
            PG8_LDB(B0, 0, 0); PG8_SCHED; PG8_LDA(At, 0, 0); PG8_STAGE(PG8_SA(1, 1), a1 + hstepA, voffA);
            PG8_WAIT_L(8); PG8_BAR; PG8_WAIT_L(0); PG8_MMA(0, 0, At, B0); PG8_BAR; PG8_SCHED;
            PG8_LDB(B1, 0, 1); PG8_STAGE(PG8_SB(0, 0), b2, voffB);
            PG8_BAR; PG8_WAIT_L(0); PG8_MMA(0, 1, At, B1); PG8_BAR;
            PG8_LDA(At, 0, 1); PG8_STAGE(PG8_SA(0, 0), a2, voffA);
            PG8_BAR; PG8_WAIT_L(0); PG8_MMA(1, 0, At, B0); PG8_BAR; PG8_SCHED;
            PG8_STAGE(PG8_SB(0, 1), b2 + hstepB, voffB);
            PG8_WAIT_V(6); PG8_BAR; PG8_MMA(1, 1, At, B1); PG8_BAR;
            PG8_LDB(B0, 1, 0); PG8_SCHED; PG8_LDA(At, 1, 0); PG8_STAGE(PG8_SA(0, 1), a2 + hstepA, voffA);
            PG8_WAIT_L(8); PG8_BAR; PG8_WAIT_L(0); PG8_MMA(0, 0, At, B0); PG8_BAR; PG8_SCHED;
            PG8_LDB(B1, 1, 1); PG8_STAGE(PG8_SB(1, 0), b3, voffB);
            PG8_BAR; PG8_WAIT_L(0); PG8_MMA(0, 1, At, B1); PG8_BAR;
            PG8_LDA(At, 1, 1); PG8_STAGE(PG8_SA(1, 0), a3, voffA);
            PG8_BAR; PG8_WAIT_L(0); PG8_MMA(1, 0, At, B0); PG8_BAR; PG8_SCHED;
            PG8_STAGE(PG8_SB(1, 1), b3 + hstepB, voffB);
            PG8_WAIT_V(6); PG8_BAR; PG8_MMA(1, 1, At, B1); PG8_BAR;
        }
        E(acc, cur, wr, wc, fr, fq);
        if (!has_next) break;
#pragma unroll
        for (int a = 0; a < 2; ++a)
#pragma unroll
            for (int b = 0; b < 2; ++b)
#pragma unroll
                for (int m = 0; m < 4; ++m)
#pragma unroll
                    for (int n = 0; n < 2; ++n) acc[a][b][m][n] = (f32x4){0.f, 0.f, 0.f, 0.f};
        cur = nxt; cA = nA; cB = nB; ++ui;
    }
    PG8_WAIT_V(0);
    if (wr == 0) PG8_BAR;
    PG8_BAR;
#undef PG8_SA
#undef PG8_SB
#undef PG8_STAGE
#undef PG8_LDA
#undef PG8_LDB
#undef PG8_MMA
#undef PG8_WAIT_V
#undef PG8_WAIT_L
#undef PG8_BAR
#undef PG8_SCHED
}

struct EpiProj {
    static constexpr bool PERM = true;
    bf16_t* proj; float* small;
    DI void operator()(const f32x4 (&acc)[2][2][4][2], const Unit& u, int wr, int wc, int fr, int fq) const {
        const int row0 = u.pm * BM + wr * 64 + fr, colb = u.pn * BM + wc * 32 + 8 * fq;
#pragma unroll
        for (int ai = 0; ai < 2; ++ai)
#pragma unroll
            for (int m = 0; m < 4; ++m) { const size_t row = (size_t)(row0 + ai * HALF + m * 16);
#pragma unroll
                for (int bj = 0; bj < 2; ++bj) { const int col = colb + bj * HALF; const f32x4 v0 = acc[ai][bj][m][0], v1 = acc[ai][bj][m][1];
                    if (col < PLD) { u32x4 o; o[0] = pk2(v0[0], v0[1]); o[1] = pk2(v0[2], v0[3]); o[2] = pk2(v1[0], v1[1]); o[3] = pk2(v1[2], v1[3]); *(u32x4*)(proj + row * PLD + col) = o; }
                    else if (col < PLD + 16) { float* sp = small + row * 16 + (col - PLD); *(f32x4*)sp = v0; *(f32x4*)(sp + 4) = v1; } } }
    }
};
template <int ACT> struct EpiBf16 {
    static constexpr bool PERM = true;
    bf16_t* O; int ldc; int zc;
    DI void operator()(const f32x4 (&acc)[2][2][4][2], const Unit& u, int wr, int wc, int fr, int fq) const {
        const int row0 = u.pm * BM + wr * 64 + fr, colb = u.z * zc + u.pn * BM + wc * 32 + 8 * fq;
#pragma unroll
        for (int ai = 0; ai < 2; ++ai)
#pragma unroll
            for (int m = 0; m < 4; ++m) { const size_t row = (size_t)(row0 + ai * HALF + m * 16);
#pragma unroll
                for (int bj = 0; bj < 2; ++bj) { f32x4 v0 = acc[ai][bj][m][0], v1 = acc[ai][bj][m][1];
                    if (ACT == 1) {
#pragma unroll
                        for (int j = 0; j < 4; ++j) { const float a = fmaxf(v0[j], 0.f), b = fmaxf(v1[j], 0.f); v0[j] = a * a; v1[j] = b * b; } }
                    u32x4 o; o[0] = pk2(v0[0], v0[1]); o[1] = pk2(v0[2], v0[3]); o[2] = pk2(v1[0], v1[1]); o[3] = pk2(v1[2], v1[3]);
                    *(u32x4*)(O + row * ldc + colb + bj * HALF) = o; } }
    }
};
struct EpiResid {
    static constexpr bool PERM = false;
    float* dst; const float* src;
    DI void operator()(const f32x4 (&acc)[2][2][4][2], const Unit& u, int wr, int wc, int fr, int fq) const {
        const int row0 = u.pm * BM + wr * 64 + fr, col0 = u.pn * BM + wc * 32 + 4 * fq;
#pragma unroll
        for (int ai = 0; ai < 2; ++ai)
#pragma unroll
            for (int m = 0; m < 4; ++m) { const size_t ro = (size_t)(row0 + ai * HALF + m * 16) * 1024 + col0;
#pragma unroll
                for (int bj = 0; bj < 2; ++bj)
#pragma unroll
                    for (int n = 0; n < 2; ++n) { const size_t o = ro + bj * HALF + n * 16; const f32x4 s = *(const f32x4*)(src + o); *(f32x4*)(dst + o) = s + acc[ai][bj][m][n]; } }
    }
};
struct EpiMerge {
    static constexpr bool PERM = false;
    const bf16_t* P; bf16_t* merged;
    DI void operator()(const f32x4 (&acc)[2][2][4][2], const Unit& u, int wr, int wc, int fr, int fq) const {
        const int row0 = u.pm * BM + wr * 64 + fr, d0 = u.pn * 64 + wc * 16 + 4 * fq;
#pragma unroll
        for (int ai = 0; ai < 2; ++ai)
#pragma unroll
            for (int m = 0; m < 4; ++m) { const size_t row = (size_t)(row0 + ai * HALF + m * 16);
                float o[4] = {0.f, 0.f, 0.f, 0.f};
#pragma unroll
                for (int j = 0; j < 4; ++j) { const u32x2 pv = *(const u32x2*)(P + row * 4096 + j * 1024 + d0);
                    const float p0 = __uint_as_float(pv[0] << 16), p1 = __uint_as_float(pv[0] & 0xffff0000u), p2 = __uint_as_float(pv[1] << 16), p3 = __uint_as_float(pv[1] & 0xffff0000u);
                    o[0] += sigmoidf_(acc[ai][0][m][0][j]) * p0; o[1] += sigmoidf_(acc[ai][0][m][1][j]) * p1;
                    o[2] += sigmoidf_(acc[ai][1][m][0][j]) * p2; o[3] += sigmoidf_(acc[ai][1][m][1][j]) * p3; }
                u32x2 ov; ov[0] = pk2(o[0], o[1]); ov[1] = pk2(o[2], o[3]);
                *(u32x2*)(merged + row * 1024 + d0) = ov; }
    }
};
}

template <class F>
DI void convert_mat(bf16_t* dst, int N, int Kd, F elem, float* tl, const int tid) {
    const int ntn = N / 64, ntk = Kd / 64;
    for (int tile = blockIdx.x; tile < ntn * ntk; tile += gridDim.x) {
        const int tn = tile % ntn, tk = tile / ntn;
        __syncthreads();
#pragma unroll
        for (int e = 0; e < 8; ++e) { const int idx = tid + e * NTHR; const int k = idx >> 6, n = idx & 63; tl[k * 65 + n] = elem(tn * 64 + n, tk * 64 + k); }
        __syncthreads();
#pragma unroll
        for (int e = 0; e < 4; ++e) { const int idx = tid + e * NTHR; const int n = idx >> 5, k2 = (idx & 31) * 2;
            *(unsigned*)(dst + (size_t)(tn * 64 + n) * Kd + tk * 64 + k2) = pk2(tl[k2 * 65 + n], tl[(k2 + 1) * 65 + n]); }
    }
}

DI void rmsnorm_phase(const float* x, const float* g, bf16_t* h, int ntok, const int tid) {
    const int lane = tid & 63, wv = tid >> 6;
    for (int t = blockIdx.x * 8 + wv; t < ntok; t += gridDim.x * 8) {
        const f32x4* xr = (const f32x4*)(x + (size_t)t * 1024);
        f32x4 v[4]; float ss = 0.f;
#pragma unroll
        for (int c = 0; c < 4; ++c) { v[c] = xr[lane + 64 * c]; ss += v[c][0] * v[c][0] + v[c][1] * v[c][1] + v[c][2] * v[c][2] + v[c][3] * v[c][3]; }
        ss = wave_sum(ss);
        const float rs = rsqrtf(ss * (1.f / 1024.f) + NEPS);
#pragma unroll
        for (int c = 0; c < 4; ++c) { const f32x4 gg = ((const f32x4*)g)[lane + 64 * c]; u32x2 o; o[0] = pk2(v[c][0] * rs * gg[0], v[c][1] * rs * gg[1]); o[1] = pk2(v[c][2] * rs * gg[2], v[c][3] * rs * gg[3]);
            *(u32x2*)(h + (size_t)t * 1024 + (lane + 64 * c) * 4) = o; }
    }
}

DI void transpose_v_item(const bf16_t* src, int ld, bf16_t* vt, int s0, bf16_t* ts  , const int tid) {
    __syncthreads();
    { const int row = tid >> 3, seg = tid & 7; const u32x4 a = *(const u32x4*)(src + (size_t)row * ld + seg * 16), b = *(const u32x4*)(src + (size_t)row * ld + seg * 16 + 8);
      unsigned* d = (unsigned*)(ts + row * 130 + seg * 16);
      d[0] = a[0]; d[1] = a[1]; d[2] = a[2]; d[3] = a[3]; d[4] = b[0]; d[5] = b[1]; d[6] = b[2]; d[7] = b[3]; }
    __syncthreads();
    { const int dv = tid >> 2, part = tid & 3; u32x4 o0, o1;
#pragma unroll
      for (int e = 0; e < 4; ++e) { o0[e] = (unsigned)ts[(part * 16 + 2 * e) * 130 + dv] | ((unsigned)ts[(part * 16 + 2 * e + 1) * 130 + dv] << 16);
                                    o1[e] = (unsigned)ts[(part * 16 + 8 + 2 * e) * 130 + dv] | ((unsigned)ts[(part * 16 + 8 + 2 * e + 1) * 130 + dv] << 16); }
      bf16_t* d = vt + (size_t)dv * SEQ + s0 + part * 16; *(u32x4*)d = o0; *(u32x4*)(d + 8) = o1; }
}

struct DnPrepArgs { const bf16_t* proj; const float* small; const float* convw; const float* alog; const float* dtb;
                    bf16_t *qdec, *negw, *u, *kdT, *aqk; float* glast; };
DI void dn_prep_item(int item, const DnPrepArgs& a, unsigned char* smem, const int tid) {
    const int lane = tid & 63, wv = tid >> 6;
    const int bh = item >> 6, n = item & 63, b = bh >> 2, h = bh & 3;
    const int t0 = b * SEQ + n * 64, s0 = n * 64;
    float* X = (float*)smem; float* R1 = (float*)(smem + 65536); bf16_t* qs = (bf16_t*)(smem + 98304); bf16_t* ks = (bf16_t*)(smem + 115712);
    float* Lm = (float*)(smem + 133120); float* gcs = (float*)(smem + 150528); float* betas = gcs + 64;
    __syncthreads();
    if (tid < 64) {
        const float al = a.small[(size_t)(t0 + tid) * 16 + h], bl = a.small[(size_t)(t0 + tid) * 16 + 4 + h];
        const float xx = al + a.dtb[h]; const float sp = xx > 20.f ? xx : log1pf(__expf(xx));
        float g = -__expf(a.alog[h]) * sp;
        for (int o = 1; o < 64; o <<= 1) { const float t = __shfl_up(g, o); if (lane >= o) g += t; }
        gcs[tid] = g; betas[tid] = sigmoidf_(bl);
    }
    __syncthreads();
    for (int part = 0; part < 3; ++part) {
        { const int seg = tid >> 7, c = tid & 127, col = part * 512 + h * 128 + c;
          const float w0 = a.convw[col], w1 = a.convw[1536 + col], w2 = a.convw[2 * 1536 + col], w3 = a.convw[3 * 1536 + col];
          const bf16_t* src = a.proj + (size_t)t0 * PLD + col; const int tt0 = seg * 16;
          float xm3 = (s0 + tt0 - 3 >= 0) ? bf2f(src[(long)(tt0 - 3) * PLD]) : 0.f;
          float xm2 = (s0 + tt0 - 2 >= 0) ? bf2f(src[(long)(tt0 - 2) * PLD]) : 0.f;
          float xm1 = (s0 + tt0 - 1 >= 0) ? bf2f(src[(long)(tt0 - 1) * PLD]) : 0.f;
          for (int e = 0; e < 16; ++e) { const int tt = tt0 + e; const float x0 = bf2f(src[(long)tt * PLD]);
              const float y = siluf_(w0 * xm3 + w1 * xm2 + w2 * xm1 + w3 * x0);
              if (part < 2) R1[tt * 128 + c] = y; else X[tt * 256 + c] = y * betas[tt];
              xm3 = xm2; xm2 = xm1; xm1 = x0; } }
        if (part < 2) {
            __syncthreads();
            const int tt = tid >> 3, sub = tid & 7; float v[16]; float ss = 0.f;
#pragma unroll
            for (int e = 0; e < 16; ++e) { v[e] = R1[tt * 128 + sub * 16 + e]; ss += v[e] * v[e]; }
            ss += __shfl_xor(ss, 1); ss += __shfl_xor(ss, 2); ss += __shfl_xor(ss, 4);
            const float rinv = rsqrtf(ss + NEPS);
            if (part == 0) {
#pragma unroll
                for (int e = 0; e < 16; ++e) qs[tt * 136 + sub * 16 + e] = f2bf(v[e] * rinv * 0.08838834764831845f);
            } else { const float f = betas[tt] * __expf(gcs[tt]);
#pragma unroll
                for (int e = 0; e < 16; ++e) { const float kn = v[e] * rinv; ks[tt * 136 + sub * 16 + e] = f2bf(kn); X[tt * 256 + 128 + sub * 16 + e] = kn * f; } }
            __syncthreads();
        }
    }
    __syncthreads();
    {
        const int r = lane & 31, h2 = lane >> 5, w4 = wv & 3, ib = w4 >> 1, jb = w4 & 1;
        const bf16_t* Am = (wv < 4) ? ks : qs;
        f32x16 acc; for (int i = 0; i < 16; ++i) acc[i] = 0.f;
#pragma unroll
        for (int s = 0; s < 8; ++s) { const bf16x8 av = *(const bf16x8*)(Am + (32 * ib + r) * 136 + 16 * s + 8 * h2), bv = *(const bf16x8*)(ks + (32 * jb + r) * 136 + 16 * s + 8 * h2);
            acc = MFMA32(av, bv, acc); }
        const int j = 32 * jb + r; const float gj = gcs[j];
        bf16_t* aq = a.aqk + (size_t)item * 4096;
#pragma unroll
        for (int i2 = 0; i2 < 16; ++i2) { const int i = 32 * ib + crow(i2, h2); const float gi = gcs[i];
            if (wv < 4) { Lm[i * 68 + j] = (j < i) ? betas[i] * acc[i2] * __expf(gi - gj) : 0.f; }
            else { aq[i * 64 + j] = f2bf((j <= i) ? acc[i2] * __expf(gi - gj) : 0.f); } }
    }
    __syncthreads();
    if (tid < 256) { const int c = tid;
        for (int i = 1; i < 64; ++i) { float acc = X[i * 256 + c]; const int nj = (i + 3) >> 2;
            for (int jj = 0; jj < nj; ++jj) { const f32x4 l4 = *(const f32x4*)(Lm + i * 68 + 4 * jj);
                acc -= (l4[0] * X[(4 * jj) * 256 + c] + l4[1] * X[(4 * jj + 1) * 256 + c]) + (l4[2] * X[(4 * jj + 2) * 256 + c] + l4[3] * X[(4 * jj + 3) * 256 + c]); }
            X[i * 256 + c] = acc; } }
    __syncthreads();
    {
        const int tt = tid >> 3, seg = tid & 7; const float eg = __expf(gcs[tt]);
        u32x4 o0, o1;
        const float* xr = X + tt * 256 + seg * 16;
#pragma unroll
        for (int e = 0; e < 4; ++e) { o0[e] = pk2(xr[2 * e], xr[2 * e + 1]); o1[e] = pk2(xr[8 + 2 * e], xr[8 + 2 * e + 1]); }
        bf16_t* d = a.u + (size_t)item * 8192 + tt * 128 + seg * 16; *(u32x4*)d = o0; *(u32x4*)(d + 8) = o1;
        xr += 128;
#pragma unroll
        for (int e = 0; e < 4; ++e) { o0[e] = pk2(-xr[2 * e], -xr[2 * e + 1]); o1[e] = pk2(-xr[8 + 2 * e], -xr[8 + 2 * e + 1]); }
        d = a.negw + (size_t)item * 8192 + tt * 128 + seg * 16; *(u32x4*)d = o0; *(u32x4*)(d + 8) = o1;
        const bf16_t* qr = qs + tt * 136 + seg * 16;
#pragma unroll
        for (int e = 0; e < 4; ++e) { o0[e] = pk2(bf2f(qr[2 * e]) * eg, bf2f(qr[2 * e + 1]) * eg); o1[e] = pk2(bf2f(qr[8 + 2 * e]) * eg, bf2f(qr[8 + 2 * e + 1]) * eg); }
        d = a.qdec + (size_t)item * 8192 + tt * 128 + seg * 16; *(u32x4*)d = o0; *(u32x4*)(d + 8) = o1;
        const int dk = tid >> 2, part = tid & 3; const float gl = gcs[63];
#pragma unroll
        for (int e = 0; e < 4; ++e) { const int ta = part * 16 + 2 * e, tb = part * 16 + 8 + 2 * e;
            o0[e] = pk2(bf2f(ks[ta * 136 + dk]) * __expf(gl - gcs[ta]), bf2f(ks[(ta + 1) * 136 + dk]) * __expf(gl - gcs[ta + 1]));
            o1[e] = pk2(bf2f(ks[tb * 136 + dk]) * __expf(gl - gcs[tb]), bf2f(ks[(tb + 1) * 136 + dk]) * __expf(gl - gcs[tb + 1])); }
        d = a.kdT + (size_t)item * 8192 + dk * 64 + part * 16; *(u32x4*)d = o0; *(u32x4*)(d + 8) = o1;
        if (tid == 0) a.glast[item] = __expf(gl);
    }
}

struct DnScanArgs { const bf16_t *qdec, *negw, *u, *kdT, *aqk; const float* glast; bf16_t* obuf; };
DI void dn_scan_item(int bh, const DnScanArgs& a, unsigned char* smem, const int tid) {
    const int lane = tid & 63, wv = tid >> 6, r = lane & 31, h2 = lane >> 5;
    const int b = bh >> 2, h = bh & 3;
    constexpr int BUFB = (3 * 64 * 136 + 64 * 72 + 128 * 72) * 2;
    __syncthreads();
#define DN_LOAD(n_) do { const size_t item_ = (size_t)bh * 64 + (n_); bf16_t* sW_ = (bf16_t*)(smem + ((n_) & 1) * BUFB); bf16_t* sQ_ = sW_ + 64 * 136; bf16_t* sU_ = sQ_ + 64 * 136; bf16_t* sA_ = sU_ + 64 * 136; bf16_t* sK_ = sA_ + 64 * 72; \
        const int lt_ = tid - 256; u32x4 w_[4], q_[4], u_[4], k_[4], a_[2]; \
        _Pragma("unroll") for (int i = 0; i < 4; ++i) { const int c = lt_ + 256 * i; const size_t o = item_ * 8192 + (size_t)(c >> 4) * 128 + (c & 15) * 8; \
            w_[i] = *(const u32x4*)(a.negw + o); q_[i] = *(const u32x4*)(a.qdec + o); u_[i] = *(const u32x4*)(a.u + o); k_[i] = *(const u32x4*)(a.kdT + item_ * 8192 + (size_t)(c >> 3) * 64 + (c & 7) * 8); } \
        _Pragma("unroll") for (int i = 0; i < 2; ++i) { const int c = lt_ + 256 * i; a_[i] = *(const u32x4*)(a.aqk + item_ * 4096 + (size_t)(c >> 3) * 64 + (c & 7) * 8); } \
        _Pragma("unroll") for (int i = 0; i < 4; ++i) { const int c = lt_ + 256 * i; const int o = (c >> 4) * 136 + (c & 15) * 8; \
            *(u32x4*)(sW_ + o) = w_[i]; *(u32x4*)(sQ_ + o) = q_[i]; *(u32x4*)(sU_ + o) = u_[i]; *(u32x4*)(sK_ + (c >> 3) * 72 + (c & 7) * 8) = k_[i]; } \
        _Pragma("unroll") for (int i = 0; i < 2; ++i) { const int c = lt_ + 256 * i; *(u32x4*)(sA_ + (c >> 3) * 72 + (c & 7) * 8) = a_[i]; } } while (0)
    if (wv >= 4) DN_LOAD(0);
    __syncthreads();
    if (wv >= 4) {
        for (int n = 0; n < 64; ++n) { if (n + 1 < 64) DN_LOAD(n + 1); __syncthreads(); }
    } else {
        f32x16 S[4];
#pragma unroll
        for (int k = 0; k < 4; ++k) for (int i = 0; i < 16; ++i) S[k][i] = 0.f;
        bf16x8 If[2];
#pragma unroll
        for (int s = 0; s < 2; ++s) for (int j = 0; j < 8; ++j) If[s][j] = ((16 * s + 8 * (j >> 2) + 4 * h2 + (j & 3)) == r) ? (short)0x3F80 : (short)0;
        for (int n = 0; n < 64; ++n) {
            const bf16_t* sW = (const bf16_t*)(smem + (n & 1) * BUFB); const bf16_t* sQ = sW + 64 * 136; const bf16_t* sU = sQ + 64 * 136; const bf16_t* sA = sU + 64 * 136; const bf16_t* sK = sA + 64 * 72;
            const float gl = a.glast[(size_t)bh * 64 + n];
            bf16x8 Sf[4][2];
#pragma unroll
            for (int kb = 0; kb < 4; ++kb) { Sf[kb][0] = pack8(S[kb], 0); Sf[kb][1] = pack8(S[kb], 1); }
            bf16x8 Vf[2][2];
#pragma unroll
            for (int tb = 0; tb < 2; ++tb) {
                f32x16 acc; for (int i = 0; i < 16; ++i) acc[i] = 0.f;
#pragma unroll
                for (int kb = 0; kb < 4; ++kb)
#pragma unroll
                    for (int s = 0; s < 2; ++s) acc = MFMA32(ld_perm(sW + (32 * tb + r) * 136 + 32 * kb + 16 * s + 4 * h2), Sf[kb][s], acc);
#pragma unroll
                for (int s = 0; s < 2; ++s) acc = MFMA32(ld_perm(sU + (32 * tb + r) * 136 + 32 * wv + 16 * s + 4 * h2), If[s], acc);
                Vf[tb][0] = pack8(acc, 0); Vf[tb][1] = pack8(acc, 1);
            }
#pragma unroll
            for (int ib = 0; ib < 2; ++ib) {
                f32x16 acc; for (int i = 0; i < 16; ++i) acc[i] = 0.f;
#pragma unroll
                for (int kb = 0; kb < 4; ++kb)
#pragma unroll
                    for (int s = 0; s < 2; ++s) acc = MFMA32(ld_perm(sQ + (32 * ib + r) * 136 + 32 * kb + 16 * s + 4 * h2), Sf[kb][s], acc);
#pragma unroll
                for (int tb = 0; tb < 2; ++tb)
#pragma unroll
                    for (int s = 0; s < 2; ++s) acc = MFMA32(ld_perm(sA + (32 * ib + r) * 72 + 32 * tb + 16 * s + 4 * h2), Vf[tb][s], acc);
                bf16_t* op = a.obuf + (size_t)(b * SEQ + n * 64 + 32 * ib) * 2048 + h * 128 + 32 * wv + r;
#pragma unroll
                for (int i = 0; i < 16; ++i) op[(size_t)crow(i, h2) * 2048] = f2bf(acc[i]);
            }
#pragma unroll
            for (int kb = 0; kb < 4; ++kb) {
                f32x16 acc = S[kb];
#pragma unroll
                for (int i = 0; i < 16; ++i) acc[i] *= gl;
#pragma unroll
                for (int tb = 0; tb < 2; ++tb)
#pragma unroll
                    for (int s = 0; s < 2; ++s) acc = MFMA32(ld_perm(sK + (32 * kb + r) * 72 + 32 * tb + 16 * s + 4 * h2), Vf[tb][s], acc);
                S[kb] = acc;
            }
            __syncthreads();
        }
    }
#undef DN_LOAD
}

template <int DK, bool DECAY>
DI void attn_item(const bf16_t* Q, int ldq, const bf16_t* Kp, int ldk, const bf16_t* Vt, const float* cum, bf16_t* O, int ldo, int qt, float scale, unsigned char* smem, const int tid) {
    constexpr int KLD = DK + 8, NKC = DK / 8, NKL = (64 * NKC) / NTHR, KS = DK / 16;
    constexpr int STAGE = 64 * KLD * 2 + 128 * 72 * 2 + 256;
    const int lane = tid & 63, wv = tid >> 6, r = lane & 31, h2 = lane >> 5;
    const int q0 = qt * 256 + wv * 32;
    bf16x8 qf[KS];
#pragma unroll
    for (int ks = 0; ks < KS; ++ks) qf[ks] = *(const bf16x8*)(Q + (size_t)(q0 + r) * ldq + 16 * ks + 8 * h2);
    const float sc2 = scale * LOG2E;
    const float cq = DECAY ? cum[q0 + r] * LOG2E : 0.f;
    f32x16 oacc[4];
#pragma unroll
    for (int d = 0; d < 4; ++d) for (int i = 0; i < 16; ++i) oacc[d][i] = 0.f;
    float m_run = -INFINITY, l_run = 0.f;
    const int ntiles = (qt + 1) * 4;
    u32x4 pk_[NKL], pv_[2]; float pc_ = 0.f;
    auto issue = [&](int j) {
        const int k0 = j * 64;
#pragma unroll
        for (int i = 0; i < NKL; ++i) { const int c = tid + i * NTHR, row = c / NKC, cc = c % NKC; pk_[i] = *(const u32x4*)(Kp + (size_t)(k0 + row) * ldk + cc * 8); }
#pragma unroll
        for (int i = 0; i < 2; ++i) { const int c = tid + i * NTHR, row = c >> 3, cc = c & 7; pv_[i] = *(const u32x4*)(Vt + (size_t)row * SEQ + k0 + cc * 8); }
        if (DECAY && tid < 64) pc_ = cum[k0 + tid] * LOG2E;
    };
    __syncthreads();
    issue(0);
    for (int j = 0; j < ntiles; ++j) {
        unsigned char* st = smem + (j & 1) * STAGE;
        bf16_t* Ks = (bf16_t*)st; bf16_t* Vs = (bf16_t*)(st + 64 * KLD * 2); float* cks = (float*)(st + 64 * KLD * 2 + 128 * 72 * 2);
#pragma unroll
        for (int i = 0; i < NKL; ++i) { const int c = tid + i * NTHR, row = c / NKC, cc = c % NKC; *(u32x4*)(Ks + row * KLD + cc * 8) = pk_[i]; }
#pragma unroll
        for (int i = 0; i < 2; ++i) { const int c = tid + i * NTHR, row = c >> 3, cc = c & 7; *(u32x4*)(Vs + row * 72 + cc * 8) = pv_[i]; }
        if (DECAY && tid < 64) cks[tid] = pc_;
        __syncthreads();
        if (j + 1 < ntiles) issue(j + 1);
        const int k0 = j * 64;
        if (k0 <= q0 + 31) {
            f32x16 sacc[2];
#pragma unroll
            for (int kb = 0; kb < 2; ++kb) { for (int i = 0; i < 16; ++i) sacc[kb][i] = 0.f;
#pragma unroll
                for (int ks = 0; ks < KS; ++ks) sacc[kb] = MFMA32(*(const bf16x8*)(Ks + (32 * kb + r) * KLD + 16 * ks + 8 * h2), qf[ks], sacc[kb]); }
            const bool masked = (k0 + 63 > q0);
            const int qpos = q0 + r;
            float mx = -INFINITY;
#pragma unroll
            for (int kb = 0; kb < 2; ++kb)
#pragma unroll
                for (int i = 0; i < 16; ++i) { const int kl = 32 * kb + crow(i, h2); float s = sacc[kb][i] * sc2;
                    if (DECAY) s += cq - cks[kl];
                    if (masked && (k0 + kl > qpos)) s = -INFINITY;
                    sacc[kb][i] = s; mx = fmaxf(mx, s); }
            mx = fmaxf(mx, __shfl_xor(mx, 32));
            const float m_new = fmaxf(m_run, mx);
            const float alpha = exp2f(m_run - m_new);
            float rs = 0.f;
#pragma unroll
            for (int kb = 0; kb < 2; ++kb)
#pragma unroll
                for (int i = 0; i < 16; ++i) { const float p = exp2f(sacc[kb][i] - m_new); sacc[kb][i] = p; rs += p; }
            rs += __shfl_xor(rs, 32);
            l_run = l_run * alpha + rs; m_run = m_new;
#pragma unroll
            for (int d = 0; d < 4; ++d)
#pragma unroll
                for (int i = 0; i < 16; ++i) oacc[d][i] *= alpha;
            bf16x8 pf[2][2];
#pragma unroll
            for (int kb = 0; kb < 2; ++kb) { pf[kb][0] = pack8(sacc[kb], 0); pf[kb][1] = pack8(sacc[kb], 1); }
#pragma unroll
            for (int d = 0; d < 4; ++d)
#pragma unroll
                for (int kb = 0; kb < 2; ++kb)
#pragma unroll
                    for (int s = 0; s < 2; ++s) oacc[d] = MFMA32(ld_perm(Vs + (32 * d + r) * 72 + 32 * kb + 16 * s + 4 * h2), pf[kb][s], oacc[d]);
        }
    }
    const float inv = 1.f / l_run;
    bf16_t* op = O + (size_t)(q0 + r) * ldo;
#pragma unroll
    for (int d = 0; d < 4; ++d)
#pragma unroll
        for (int i4 = 0; i4 < 4; ++i4) { u32x2 o; o[0] = pk2(oacc[d][4 * i4] * inv, oacc[d][4 * i4 + 1] * inv); o[1] = pk2(oacc[d][4 * i4 + 2] * inv, oacc[d][4 * i4 + 3] * inv);
            *(u32x2*)(op + 32 * d + 8 * i4 + 4 * h2) = o; }
}

DI void sg_item(int item, const bf16_t* proj, const bf16_t* sgw, const float* vng, const float* bs, bf16_t* obuf, unsigned char* smem, const int tid) {
    const int lane = tid & 63, wv = tid >> 6, r = lane & 31, h2 = lane >> 5;
    const int g = item & 3, n = (item >> 2) & 31, b = item >> 7;
    const int t0 = b * SEQ + n * 128;
    bf16_t* vT = (bf16_t*)smem;
    __syncthreads();
    for (int e = 0; e < 16; ++e) { const int tt = wv * 16 + e;
        const bf16_t* vr = proj + (size_t)(t0 + tt) * PLD + 3008 + g * 128;
        const float a0 = geluf_(bf2f(vr[lane])), a1 = geluf_(bf2f(vr[lane + 64]));
        const float ss = wave_sum(a0 * a0 + a1 * a1); const float rs = rsqrtf(ss * (1.f / 128.f) + NEPS);
        vT[lane * 136 + tt] = f2bf(a0 * rs * vng[g * 128 + lane]); vT[(lane + 64) * 136 + tt] = f2bf(a1 * rs * vng[g * 128 + lane + 64]); }
    __syncthreads();
    const int tb = wv >> 1;
    const bf16_t* W = sgw + (size_t)g * 16384;
#pragma unroll
    for (int ci = 0; ci < 2; ++ci) { const int cb = 2 * (wv & 1) + ci;
        f32x16 acc; for (int i = 0; i < 16; ++i) acc[i] = 0.f;
        for (int ks = 0; ks < 2 * (tb + 1); ++ks) { const bf16x8 av = *(const bf16x8*)(W + (32 * tb + r) * 128 + 16 * ks + 8 * h2), bv = *(const bf16x8*)(vT + (32 * cb + r) * 136 + 16 * ks + 8 * h2);
            acc = MFMA32(av, bv, acc); }
        const int c = 32 * cb + r;
#pragma unroll
        for (int i = 0; i < 16; ++i) { const int t = 32 * tb + crow(i, h2);
            const float uu = geluf_(bf2f(proj[(size_t)(t0 + t) * PLD + 2496 + g * 128 + c]));
            obuf[(size_t)(t0 + t) * 2048 + 1024 + g * 128 + c] = f2bf(uu * (acc[i] + bs[g * 128 + t])); } }
}

#define PIN(k) (p.in[k])
#define POUT (p.out)
DI void run_phase(const Params& p, int ph, unsigned char* smem, const int tid) {
    const int l = ph / N_STEPS, s = ph % N_STEPS;
    const int lane = tid & 63, wv = tid >> 6;
    unsigned char* ws = p.ws;
    bf16_t* wt_in = (bf16_t*)(ws + OFF_WT_IN); bf16_t* wt_gate = (bf16_t*)(ws + OFF_WT_GATE); bf16_t* wt_mla = (bf16_t*)(ws + OFF_WT_MLA); bf16_t* wt_br = (bf16_t*)(ws + OFF_WT_BR);
    bf16_t* wt_out = (bf16_t*)(ws + OFF_WT_OUT); bf16_t* wt_ff1 = (bf16_t*)(ws + OFF_WT_FF1); bf16_t* wt_ff2 = (bf16_t*)(ws + OFF_WT_FF2); bf16_t* sgw = (bf16_t*)(ws + OFF_SGW);
    bf16_t* hbuf = (bf16_t*)(ws + OFF_HBUF); bf16_t* proj = (bf16_t*)(ws + OFF_PROJ); float* small = (float*)(ws + OFF_SMALL);
    bf16_t* mlaa = (bf16_t*)(ws + OFF_MLAA); bf16_t* mlaraw = (bf16_t*)(ws + OFF_MLARAW); bf16_t* mlaq = (bf16_t*)(ws + OFF_MLAQ); bf16_t* mlak = (bf16_t*)(ws + OFF_MLAK);
    bf16_t* mlavt = (bf16_t*)(ws + OFF_MLAVT); bf16_t* foxvt = (bf16_t*)(ws + OFF_FOXVT); float* foxcum = (float*)(ws + OFF_FOXCUM);
    bf16_t* obuf = (bf16_t*)(ws + OFF_OBUF); bf16_t* Pb = (bf16_t*)(ws + OFF_P); bf16_t* merged = (bf16_t*)(ws + OFF_MERGED); bf16_t* hid = (bf16_t*)(ws + OFF_HID);
    unsigned* ctr = (unsigned*)ws;
    LAS unsigned char* lds = (LAS unsigned char*)smem;
    const float* xsrc = (l == 0) ? PIN(0) : POUT;

    if (s == 0) {
        float* tl = (float*)smem;
        { const float* w = PIN(3) + (size_t)l * 1024 * 9164;
          convert_mat(wt_in, 5120, 1024, [&](int n, int k) -> float { int sc; if (n < 2048) sc = n; else if (n < 5056) sc = n + 8; else if (n < 5064) sc = n - 5056 + 2048; else if (n < 5068) sc = n; else sc = -1;
              return sc >= 0 ? w[(size_t)k * 9164 + sc] : 0.f; }, tl, tid);
          convert_mat(wt_gate, 4096, 1024, [&](int n, int k) -> float { const int pn = n >> 8, c = n & 255, bj = c >> 7, wc = (c >> 5) & 3, nn = (c >> 4) & 1, fq = (c >> 2) & 3, j = c & 3;
              const int d = 64 * pn + 16 * wc + 4 * fq + 2 * bj + nn; return w[(size_t)k * 9164 + 5068 + j * 1024 + d]; }, tl, tid); }
        { const float* wq = PIN(10) + (size_t)l * 256 * 768; const float* wkv = PIN(11) + (size_t)l * 128 * 1024;
          convert_mat(wt_mla, 1792, 384, [&](int n, int k) -> float { if (n < 768) return k < 256 ? wq[(size_t)k * 768 + n] : 0.f; return k >= 256 ? wkv[(size_t)(k - 256) * 1024 + (n - 768)] : 0.f; }, tl, tid); }
        { const float* w = PIN(20) + (size_t)l * 4 * 512 * 1024; convert_mat(wt_br, 4096, 512, [&](int n, int k) -> float { return w[((size_t)(n >> 10) * 512 + k) * 1024 + (n & 1023)]; }, tl, tid); }
        { const float* w = PIN(21) + (size_t)l * 1024 * 1024; convert_mat(wt_out, 1024, 1024, [&](int n, int k) -> float { return w[(size_t)k * 1024 + n]; }, tl, tid); }
        { const float* w = PIN(23) + (size_t)l * 1024 * 4096; convert_mat(wt_ff1, 4096, 1024, [&](int n, int k) -> float { return w[(size_t)k * 4096 + n]; }, tl, tid); }
        { const float* w = PIN(24) + (size_t)l * 4096 * 1024; convert_mat(wt_ff2, 1024, 4096, [&](int n, int k) -> float { return w[(size_t)k * 1024 + n]; }, tl, tid); }
        { const float* w = PIN(15) + (size_t)l * 4 * 128 * 128;
          for (int i = blockIdx.x * NTHR + tid; i < 4 * 128 * 128; i += gridDim.x * NTHR) { const int t = (i >> 7) & 127, sx = i & 127; sgw[i] = f2bf(sx <= t ? w[i] : 0.f); } }
        rmsnorm_phase(xsrc, PIN(2) + l * 1024, hbuf, 65536, tid);
        return;
    }
    if (s == 19) { rmsnorm_phase(POUT, PIN(22) + l * 1024, hbuf, 65536, tid); return; }
    if (s == 20) { pg8::Gemm g{hbuf, wt_ff1, 1024, 1024, 1024, 256, 16, 1, 0, 0}; pg8::EpiBf16<1> E{hid, 4096, 0}; pg8::gemm_phase(lds, g, E, tid); return; }
    if (s == 21) { pg8::Gemm g{hid, wt_ff2, 4096, 4096, 4096, 256, 4, 1, 0, 0}; pg8::EpiResid E{POUT, POUT}; pg8::gemm_phase(lds, g, E, tid); return; }

    const int hb = (s - 1) / 9, st = (s - 1) % 9 + 1;
    const size_t tok0 = (size_t)hb * TS;
    switch (st) {
    case 1: { pg8::Gemm g{hbuf + tok0 * 1024, wt_in, 1024, 1024, 1024, 128, 20, 1, 0, 0}; pg8::EpiProj E{proj, small}; pg8::gemm_phase(lds, g, E, tid); } break;
    case 2: {
        { const float* gq = PIN(8) + l * 256; const float* gkv = PIN(9) + l * 128; const float* fqg = PIN(17) + l * 128; const float* fkg = PIN(18) + l * 128;
          for (int t = blockIdx.x * 8 + wv; t < TS; t += gridDim.x * 8) { bf16_t* pr = proj + (size_t)t * PLD;
              { const u32x2 v = *(const u32x2*)(pr + 2048 + 4 * lane); const float a0 = __uint_as_float(v[0] << 16), a1 = __uint_as_float(v[0] & 0xffff0000u), a2 = __uint_as_float(v[1] << 16), a3 = __uint_as_float(v[1] & 0xffff0000u);
                const float rs = rsqrtf(wave_sum(a0 * a0 + a1 * a1 + a2 * a2 + a3 * a3) * (1.f / 256.f) + NEPS); const f32x4 gg = *(const f32x4*)(gq + 4 * lane);
                u32x2 o; o[0] = pk2(a0 * rs * gg[0], a1 * rs * gg[1]); o[1] = pk2(a2 * rs * gg[2], a3 * rs * gg[3]); *(u32x2*)(mlaa + (size_t)t * 384 + 4 * lane) = o; }
              { const unsigned v = *(const unsigned*)(pr + 2304 + 2 * lane); const float a0 = __uint_as_float(v << 16), a1 = __uint_as_float(v & 0xffff0000u);
                const float rs = rsqrtf(wave_sum(a0 * a0 + a1 * a1) * (1.f / 128.f) + NEPS);
                *(unsigned*)(mlaa + (size_t)t * 384 + 256 + 2 * lane) = pk2(a0 * rs * gkv[2 * lane], a1 * rs * gkv[2 * lane + 1]); }
#pragma unroll
              for (int hq = 0; hq < 8; ++hq) { bf16_t* qp = pr + 3520 + hq * 128 + 2 * lane; const float* gg = (hq < 4) ? fqg : fkg;
                const unsigned v = *(const unsigned*)qp; const float a0 = __uint_as_float(v << 16), a1 = __uint_as_float(v & 0xffff0000u);
                const float rs = rsqrtf(wave_sum(a0 * a0 + a1 * a1) * (1.f / 128.f) + NEPS);
                *(unsigned*)qp = pk2(a0 * rs * gg[2 * lane], a1 * rs * gg[2 * lane + 1]); } } }
        { const int gw = blockIdx.x * 8 + wv;
          if (gw < 32) { const int b = gw >> 2, h = gw & 3; const float fb = PIN(19)[l * 4 + h]; float tot = 0.f;
              for (int e = 0; e < 64; ++e) { const float x = small[(size_t)(b * SEQ + lane * 64 + e) * 16 + 8 + h] + fb; tot += fminf(x, 0.f) - log1pf(__expf(-fabsf(x))); }
              float inc = tot; for (int o = 1; o < 64; o <<= 1) { const float t = __shfl_up(inc, o); if (lane >= o) inc += t; }
              float run = inc - tot;
              for (int e = 0; e < 64; ++e) { const float x = small[(size_t)(b * SEQ + lane * 64 + e) * 16 + 8 + h] + fb; run += fminf(x, 0.f) - log1pf(__expf(-fabsf(x))); foxcum[(size_t)(b * 4 + h) * SEQ + lane * 64 + e] = run; } } }
        for (int it = blockIdx.x; it < 2048; it += gridDim.x) { const int sti = it & 63, h = (it >> 6) & 3, b = it >> 8;
            transpose_v_item(proj + (size_t)(b * SEQ + sti * 64) * PLD + 3520 + 1024 + h * 128, PLD, foxvt + (size_t)(b * 4 + h) * 128 * SEQ, sti * 64, (bf16_t*)smem, tid); }
        { DnPrepArgs a{proj, small, PIN(4) + (size_t)l * 4 * 1536, PIN(5) + l * 4, PIN(6) + l * 4,
                       (bf16_t*)(ws + OFF_DN_QDEC), (bf16_t*)(ws + OFF_DN_NEGW), (bf16_t*)(ws + OFF_DN_U), (bf16_t*)(ws + OFF_DN_KDT), (bf16_t*)(ws + OFF_DN_AQK), (float*)(ws + OFF_DN_GLAST)};
          for (int it = blockIdx.x; it < NCH; it += gridDim.x) { int tq = tid; asm volatile("" : "+v"(tq)); dn_prep_item(it, a, smem, tq); } }
    } break;
    case 3: { pg8::Gemm g{mlaa, wt_mla, 384, 384, 384, 128, 7, 1, 0, 0}; pg8::EpiBf16<0> E{mlaraw, 1792, 0}; pg8::gemm_phase(lds, g, E, tid); } break;
    case 4: {
        const float* gqq = PIN(12) + l * 192; const float* gkk = PIN(13) + l * 192; const int* pos = (const int*)PIN(1);
        const int fi = lane & 31; const float invf = powf(10000.f, -(float)(2 * fi) / 64.f);
        for (int t = blockIdx.x * 8 + wv; t < TS; t += gridDim.x * 8) {
            const float ang = (float)pos[tok0 + t] * invf; float sn, cs; sincosf(ang, &sn, &cs);
            const float kr = bf2f(proj[(size_t)t * PLD + 2432 + lane]);
#pragma unroll
            for (int h = 0; h < 4; ++h) {
                { const bf16_t* qr = mlaraw + (size_t)t * 1792 + h * 192; const float a0 = bf2f(qr[lane]), a1 = bf2f(qr[lane + 64]), a2 = bf2f(qr[lane + 128]);
                  const float rs = rsqrtf(wave_sum(a0 * a0 + a1 * a1 + a2 * a2) * (1.f / 192.f) + NEPS);
                  const float y2 = a2 * rs * gqq[128 + lane]; const float oth = __shfl_xor(y2, 32);
                  const float rot = (lane < 32) ? (y2 * cs - oth * sn) : (y2 * cs + oth * sn);
                  bf16_t* qo = mlaq + (size_t)t * 768 + h * 192; qo[lane] = f2bf(a0 * rs * gqq[lane]); qo[lane + 64] = f2bf(a1 * rs * gqq[lane + 64]); qo[lane + 128] = f2bf(rot); }
                { const bf16_t* kp = mlaraw + (size_t)t * 1792 + 768 + h * 256; const float a0 = bf2f(kp[lane]), a1 = bf2f(kp[lane + 64]);
                  const float rs = rsqrtf(wave_sum(a0 * a0 + a1 * a1 + kr * kr) * (1.f / 192.f) + NEPS);
                  const float y2 = kr * rs * gkk[128 + lane]; const float oth = __shfl_xor(y2, 32);
                  const float rot = (lane < 32) ? (y2 * cs - oth * sn) : (y2 * cs + oth * sn);
                  bf16_t* ko = mlak + (size_t)t * 768 + h * 192; ko[lane] = f2bf(a0 * rs * gkk[lane]); ko[lane + 64] = f2bf(a1 * rs * gkk[lane + 64]); ko[lane + 128] = f2bf(rot); }
            }
        }
        for (int it = blockIdx.x; it < 2048; it += gridDim.x) { const int sti = it & 63, h = (it >> 6) & 3, b = it >> 8;
            transpose_v_item(mlaraw + (size_t)(b * SEQ + sti * 64) * 1792 + 768 + h * 256 + 128, 1792, mlavt + (size_t)(b * 4 + h) * 128 * SEQ, sti * 64, (bf16_t*)smem, tid); }
    } break;
    case 5: {
        DnScanArgs da{(bf16_t*)(ws + OFF_DN_QDEC), (bf16_t*)(ws + OFF_DN_NEGW), (bf16_t*)(ws + OFF_DN_U), (bf16_t*)(ws + OFF_DN_KDT), (bf16_t*)(ws + OFF_DN_AQK), (float*)(ws + OFF_DN_GLAST), obuf};
        int* s_item = (int*)(smem + LDS_BYTES - 64);
        const int total = 32 + 1024 + 1024;
        for (;;) {
            __syncthreads();
            if (tid == 0) *s_item = (int)atomicAdd(ctr + ph, 1u);
            __syncthreads();
            const int it = *s_item;
            if (it >= total) break;
            int tq = tid; asm volatile("" : "+v"(tq));
            if (it < 32) dn_scan_item(it, da, smem, tq);
            else if (it < 32 + 1024) { const int idx = it - 32, qt = 15 - (idx >> 6), rr = idx & 63, type = rr & 1, bh = rr >> 1, b = bh >> 2, h = bh & 3;
                if (type == 0) attn_item<192, false>(mlaq + (size_t)b * SEQ * 768 + h * 192, 768, mlak + (size_t)b * SEQ * 768 + h * 192, 768, mlavt + (size_t)bh * 128 * SEQ, nullptr,
                                                     obuf + (size_t)b * SEQ * 2048 + 512 + h * 128, 2048, qt, 0.07216878364870322f, smem, tq);
                else attn_item<128, true>(proj + (size_t)b * SEQ * PLD + 3520 + h * 128, PLD, proj + (size_t)b * SEQ * PLD + 3520 + 512 + h * 128, PLD, foxvt + (size_t)bh * 128 * SEQ, foxcum + (size_t)bh * SEQ,
                                          obuf + (size_t)b * SEQ * 2048 + 1536 + h * 128, 2048, qt, 0.08838834764831845f, smem, tq); }
            else sg_item(it - 32 - 1024, proj, sgw, PIN(14) + l * 512, PIN(16) + l * 512, obuf, smem, tq);
        }
    } break;
    case 6: {
        const float* og = PIN(7) + l * 128;
        for (int t = blockIdx.x * 8 + wv; t < TS; t += gridDim.x * 8) {
#pragma unroll
            for (int h = 0; h < 4; ++h) { bf16_t* op = obuf + (size_t)t * 2048 + h * 128 + 2 * lane; const unsigned v = *(const unsigned*)op; const float a0 = __uint_as_float(v << 16), a1 = __uint_as_float(v & 0xffff0000u);
                const float rs = rsqrtf(wave_sum(a0 * a0 + a1 * a1) * (1.f / 128.f) + NEPS);
                const unsigned zv = *(const unsigned*)(proj + (size_t)t * PLD + 1536 + h * 128 + 2 * lane); const float z0 = __uint_as_float(zv << 16), z1 = __uint_as_float(zv & 0xffff0000u);
                *(unsigned*)op = pk2(a0 * rs * og[2 * lane] * siluf_(z0), a1 * rs * og[2 * lane + 1] * siluf_(z1)); } }
    } break;
    case 7: { pg8::Gemm g{obuf, wt_br, 2048, 512, 512, 128, 4, 4, 512, (long)1024 * 512}; pg8::EpiBf16<0> E{Pb, 4096, 1024}; pg8::gemm_phase(lds, g, E, tid); } break;
    case 8: { pg8::Gemm g{hbuf + tok0 * 1024, wt_gate, 1024, 1024, 1024, 128, 16, 1, 0, 0}; pg8::EpiMerge E{Pb, merged}; pg8::gemm_phase(lds, g, E, tid); } break;
    case 9: { pg8::Gemm g{merged, wt_out, 1024, 1024, 1024, 128, 4, 1, 0, 0}; pg8::EpiResid E{POUT + tok0 * 1024, xsrc + tok0 * 1024}; pg8::gemm_phase(lds, g, E, tid); } break;
    }
}

__global__ void __launch_bounds__(512, 2) mega(Params p) {
    extern __shared__ __attribute__((aligned(16))) unsigned char smem[];
    cg::grid_group grid = cg::this_grid();
    for (int ph = p.ph_lo; ph < p.ph_hi; ++ph) {
        if (ph > p.ph_lo) grid.sync();
        int tid = threadIdx.x; asm volatile("" : "+v"(tid));
        run_phase(p, ph, smem, tid);
    }
}

#ifndef N_LAUNCH_MODE
#define N_LAUNCH_MODE 0
#endif

extern "C" void kernel_launch(void* const* d_in, const int* in_sizes, int n_in, void* d_out, int out_size, void* d_ws, size_t ws_size, hipStream_t stream) {
    static int grid = 0;
    if (grid == 0) {
        if (n_in != 25 || ws_size < OFF_END) { fprintf(stderr, "kernel_launch: unexpected n_in %d or workspace %zu < %zu\n", n_in, ws_size, (size_t)OFF_END); grid = -1; return; }
        int dev = 0, cus = 0, per_cu = 0;
        hipGetDevice(&dev); hipDeviceGetAttribute(&cus, hipDeviceAttributeMultiprocessorCount, dev);
        if (hipFuncSetAttribute((const void*)mega, hipFuncAttributeMaxDynamicSharedMemorySize, LDS_BYTES) != hipSuccess) { fprintf(stderr, "kernel_launch: hipFuncSetAttribute failed\n"); grid = -1; return; }
        if (hipOccupancyMaxActiveBlocksPerMultiprocessor(&per_cu, (const void*)mega, NTHR, LDS_BYTES) != hipSuccess || per_cu < 1) { fprintf(stderr, "kernel_launch: occupancy query gave %d\n", per_cu); per_cu = 1; }
        (void)hipGetLastError();
        grid = cus * per_cu;
    }
    if (grid < 0) return;
    hipMemsetAsync(d_ws, 0, SZ_CTL, stream);
    Params p{};
    for (int i = 0; i < 25; ++i) p.in[i] = (const float*)d_in[i];
    p.out = (float*)d_out; p.ws = (unsigned char*)d_ws;
#if N_LAUNCH_MODE == 1
    p.ph_lo = 0; p.ph_hi = N_PHASES;
    void* args[] = {&p};
    hipError_t e = hipLaunchCooperativeKernel((const void*)mega, dim3(grid), dim3(NTHR), args, LDS_BYTES, stream);
    if (e != hipSuccess) fprintf(stderr, "cooperative launch failed: %s (grid %d)\n", hipGetErrorString(e), grid);
#else
    for (int ph = 0; ph < N_PHASES; ++ph) { p.ph_lo = ph; p.ph_hi = ph + 1; hipLaunchKernelGGL(mega, dim3(grid), dim3(NTHR), LDS_BYTES, stream, p); }
#endif
}
```

```cpp
#include <hip/hip_runtime.h>
#include <hip/hip_cooperative_groups.h>
#include <cstdio>
namespace cg = cooperative_groups;

#define DI __device__ __forceinline__
#define LAS __attribute__((address_space(3)))
typedef unsigned short bf16_t;
typedef short bf16x8 __attribute__((ext_vector_type(8)));
typedef short s16x4 __attribute__((ext_vector_type(4)));
typedef float f32x4 __attribute__((ext_vector_type(4)));
typedef float f32x16 __attribute__((ext_vector_type(16)));
typedef unsigned u32x4 __attribute__((ext_vector_type(4)));
typedef unsigned u32x2 __attribute__((ext_vector_type(2)));

#define PROBE_ST -1
#define PROBE_SYNCS 0
#define PROBE_SUB 0
#define PROBE_LIM 9
constexpr int TS = 32768, SEQ = 4096, PLD = 5056, NTHR = 512;
constexpr int LDS_BYTES = 160 * 1024;
constexpr int N_STEPS = 20, N_PHASES = 4 * N_STEPS;
constexpr float NEPS = 1e-6f;
constexpr float LOG2E = 1.4426950408889634f;

constexpr size_t SZ_CTL = 32768;
constexpr size_t OFF_WT_IN = SZ_CTL;
constexpr size_t OFF_WT_GATE = OFF_WT_IN + (size_t)5120 * 1024 * 2;
constexpr size_t OFF_WT_MLA = OFF_WT_GATE + (size_t)4096 * 1024 * 2;
constexpr size_t OFF_WT_BR = OFF_WT_MLA + (size_t)1792 * 384 * 2;
constexpr size_t OFF_WT_OUT = OFF_WT_BR + (size_t)4096 * 512 * 2;
constexpr size_t OFF_WT_FF1 = OFF_WT_OUT + (size_t)1024 * 1024 * 2;
constexpr size_t OFF_WT_FF2 = OFF_WT_FF1 + (size_t)4096 * 1024 * 2;
constexpr size_t OFF_SGW = OFF_WT_FF2 + (size_t)1024 * 4096 * 2;
constexpr size_t OFF_HBUF = OFF_SGW + (size_t)4 * 128 * 128 * 2;
constexpr size_t OFF_HB = OFF_HBUF + (size_t)65536 * 1024 * 2;
constexpr size_t OFF_PROJ = OFF_HB;
constexpr size_t OFF_SMALL = OFF_PROJ + (size_t)TS * PLD * 2;
constexpr size_t OFF_MLAA = OFF_SMALL + (size_t)TS * 16 * 4;
constexpr size_t OFF_MLARAW = OFF_MLAA + (size_t)TS * 384 * 2;
constexpr size_t OFF_MLAQ = OFF_MLARAW + (size_t)TS * 1792 * 2;
constexpr size_t OFF_MLAK = OFF_MLAQ + (size_t)TS * 768 * 2;
constexpr size_t OFF_MLAVT = OFF_MLAK + (size_t)TS * 768 * 2;
constexpr size_t OFF_FOXVT = OFF_MLAVT + (size_t)TS * 512 * 2;
constexpr size_t OFF_FOXCUM = OFF_FOXVT + (size_t)TS * 512 * 2;
constexpr size_t OFF_DNP = OFF_FOXCUM + (size_t)TS * 4 * 4;
constexpr int NCH = 2048;
constexpr size_t DNP_MAT = (size_t)NCH * 8192 * 2;
constexpr size_t OFF_DN_QDEC = OFF_DNP, OFF_DN_NEGW = OFF_DNP + DNP_MAT, OFF_DN_U = OFF_DNP + 2 * DNP_MAT, OFF_DN_KDT = OFF_DNP + 3 * DNP_MAT;
constexpr size_t OFF_DN_AQK = OFF_DNP + 4 * DNP_MAT;
constexpr size_t OFF_DN_GLAST = OFF_DN_AQK + (size_t)NCH * 4096 * 2;
constexpr size_t OFF_END = OFF_DN_GLAST + (size_t)NCH * 4;
constexpr size_t OFF_OBUF = OFF_MLAA;
constexpr size_t OFF_P = OFF_PROJ;
constexpr size_t OFF_MERGED = OFF_DNP;
constexpr size_t OFF_HID = OFF_HB;
static_assert((size_t)TS * 2048 * 2 <= OFF_MLAQ - OFF_MLAA, "obuf overlay");
static_assert((size_t)65536 * 4096 * 2 <= OFF_END - OFF_HB, "hid overlay");

struct Params { const float* in[25]; float* out; unsigned char* ws; int ph_lo, ph_hi; };

DI float bf2f(bf16_t b) { return __uint_as_float(((unsigned)b) << 16); }
DI bf16_t f2bf(float f) { unsigned u = __float_as_uint(f); u += 0x7fffu + ((u >> 16) & 1u); return (bf16_t)(u >> 16); }
typedef __bf16 bf16v2_t __attribute__((ext_vector_type(2)));
typedef float f32x2 __attribute__((ext_vector_type(2)));
DI unsigned pk2(float lo, float hi) { const f32x2 v = {lo, hi}; return __builtin_bit_cast(unsigned, __builtin_convertvector(v, bf16v2_t)); }
DI float wave_sum(float v) { for (int o = 32; o; o >>= 1) v += __shfl_xor(v, o); return v; }
DI float sigmoidf_(float x) { return __builtin_amdgcn_rcpf(1.f + __builtin_amdgcn_exp2f(-LOG2E * x)); }
DI float siluf_(float x) { return x * __builtin_amdgcn_rcpf(1.f + __builtin_amdgcn_exp2f(-LOG2E * x)); }
DI float geluf_(float x) { const float u = 0.7978845608028654f * (x + 0.044715f * x * x * x); return x * __builtin_amdgcn_rcpf(1.f + __builtin_amdgcn_exp2f(-2.f * LOG2E * u)); }
DI int crow(int i, int h) { return (i & 3) + 8 * (i >> 2) + 4 * h; }
#define MFMA32(a, b, c) __builtin_amdgcn_mfma_f32_32x32x16_bf16((a), (b), (c), 0, 0, 0)
DI bf16x8 pack8(const f32x16& x, int s) {
    u32x4 p;
    p[0] = pk2(x[8 * s + 0], x[8 * s + 1]); p[1] = pk2(x[8 * s + 2], x[8 * s + 3]);
    p[2] = pk2(x[8 * s + 4], x[8 * s + 5]); p[3] = pk2(x[8 * s + 6], x[8 * s + 7]);
    return __builtin_bit_cast(bf16x8, p);
}
DI bf16x8 ld_perm(const bf16_t* p) {
    const s16x4 lo = *(const s16x4*)p, hi = *(const s16x4*)(p + 8);
    return __builtin_shufflevector(lo, hi, 0, 1, 2, 3, 4, 5, 6, 7);
}

namespace pg8 {
constexpr int BM = 256, BK = 64, HALF = 128, HTB = HALF * BK * 2, NXCD = 8, WGM = 8;
DI int lds_byte(int r, int c) { const int st = (r >> 4) * 2 + (c >> 5), rr = r & 15, cc = c & 31, ob = rr * 64 + cc * 2; return st * 1024 + (ob ^ (((ob >> 9) & 1) << 5)); }
DI void stage_rc(int b, int& R, int& C) { const int st = b / 1024, sb = b % 1024, swz = sb ^ (((sb >> 9) & 1) << 5); R = (st >> 1) * 16 + swz / 64; C = (st & 1) * 32 + (swz % 64) / 2; }
DI int perm32(int rho) { const int n = rho >> 4, i = rho & 15; return 8 * (i >> 2) + 4 * n + (i & 3); }
struct Unit { int pm, pn, z; };
struct Gemm { const bf16_t* A; const bf16_t* Bt; int lda, ldb, K, nM, nN, nZ; long zA, zB; int pn_split; int a_off2; };
struct Order {
    int nM, nN, nwg, total, G, c;
    DI void init(const Gemm& g) { nM = g.nM; nN = g.nN; nwg = nM * nN; total = nwg * g.nZ; G = gridDim.x; c = blockIdx.x; }
    DI bool next(int i, Unit& u) const {
        const long L = (long)i * G + c; if (L >= total) return false;
        u.z = (int)(L / nwg); int wgid = (int)(L % nwg);
        { const int q = nwg / NXCD, r = nwg % NXCD, xcd = wgid % NXCD, off = wgid / NXCD; wgid = (xcd < r ? xcd * (q + 1) : r * (q + 1) + (xcd - r) * q) + off; }
        const int nig = WGM * nN, gid = wgid / nig, fm = gid * WGM, gsz = (nM - fm) < WGM ? (nM - fm) : WGM;
        u.pm = fm + ((wgid % nig) % gsz); u.pn = (wgid % nig) / gsz; return true;
    }
};

template <class Epi>
DI void gemm_phase(LAS unsigned char* lds, const Gemm g, const Epi& E, const int tid) {
    const int wid = __builtin_amdgcn_readfirstlane(tid >> 6), lane = tid & 63, wr = wid >> 2, wc = wid & 3, fr = lane & 15, fq = lane >> 4;
    const int K = g.K, nt = K / BK;
    Order S; S.init(g);
    unsigned voffA[2], voffB[2];
#pragma unroll
    for (int i = 0; i < 2; ++i) { int R, C; stage_rc(tid * 16 + i * 8192, R, C); const int Rb = Epi::PERM ? ((R & ~31) + perm32(R & 31)) : R;
        voffA[i] = (unsigned)(R * g.lda + C) * 2u; voffB[i] = (unsigned)(Rb * g.ldb + C) * 2u; }
    const size_t kstep = (size_t)(BK * 2);
    const size_t hstepA = (size_t)HALF * g.lda * 2, hstepB = (size_t)HALF * g.ldb * 2;
    const unsigned ldsw = (unsigned)wid * 1024u;
    const int aoff = lds_byte(wr * 64 + fr, fq * 8), boff = lds_byte(wc * 32 + fr, fq * 8);
#define PG8_SA(b, h) (((b) * 2 + (h)) * HTB)
#define PG8_SB(b, h) ((4 + (b) * 2 + (h)) * HTB)
#define PG8_STAGE(bufoff, gbase, voff) do { _Pragma("unroll") for (int _i = 0; _i < 2; ++_i) \
        __builtin_amdgcn_global_load_lds((const unsigned*)((const char*)(gbase) + (voff)[_i]), (LAS unsigned*)(lds + (bufoff) + ldsw + _i * 8192), 16, 0, 0); } while (0)
#define PG8_LDA(dst, b, h) do { _Pragma("unroll") for (int m = 0; m < 4; ++m) _Pragma("unroll") for (int k = 0; k < 2; ++k) dst[m][k] = *(const LAS bf16x8*)(lds + PG8_SA(b, h) + aoff + m * 2048 + k * 1024); } while (0)
#define PG8_LDB(dst, b, h) do { _Pragma("unroll") for (int n = 0; n < 2; ++n) _Pragma("unroll") for (int k = 0; k < 2; ++k) dst[n][k] = *(const LAS bf16x8*)(lds + PG8_SB(b, h) + boff + n * 2048 + k * 1024); } while (0)
#define PG8_MMA(ai, bj, At, Bt) do { __builtin_amdgcn_s_setprio(1); _Pragma("unroll") for (int m = 0; m < 4; ++m) _Pragma("unroll") for (int n = 0; n < 2; ++n) _Pragma("unroll") for (int k = 0; k < 2; ++k) \
        acc[ai][bj][m][n] = __builtin_amdgcn_mfma_f32_16x16x32_bf16(Bt[n][k], At[m][k], acc[ai][bj][m][n], 0, 0, 0); __builtin_amdgcn_s_setprio(0); } while (0)
#define PG8_WAIT_V(n) asm volatile("s_waitcnt vmcnt(" #n ")" ::: "memory")
#define PG8_WAIT_L(n) asm volatile("s_waitcnt lgkmcnt(" #n ")" ::: "memory")
#define PG8_BAR __builtin_amdgcn_s_barrier()
#define PG8_SCHED __builtin_amdgcn_sched_barrier(0)
    Unit cur, nxt; int ui = 0;
    if (!S.next(0, cur)) return;
    f32x4 acc[2][2][4][2];
#pragma unroll
    for (int a = 0; a < 2; ++a)
#pragma unroll
        for (int b = 0; b < 2; ++b)
#pragma unroll
            for (int m = 0; m < 4; ++m)
#pragma unroll
                for (int n = 0; n < 2; ++n) acc[a][b][m][n] = (f32x4){0.f, 0.f, 0.f, 0.f};
    bf16x8 At[4][2], B0[2][2], B1[2][2];
    const char* cA = (const char*)g.A + (size_t)cur.z * g.zA * 2 + (size_t)cur.pm * 2 * hstepA + (cur.pn >= g.pn_split ? (size_t)g.a_off2 * 2 : (size_t)0);
    const char* cB = (const char*)g.Bt + (size_t)cur.z * g.zB * 2 + (size_t)cur.pn * 2 * hstepB;
    PG8_STAGE(PG8_SB(0, 0), cB, voffB); PG8_STAGE(PG8_SB(0, 1), cB + hstepB, voffB); PG8_STAGE(PG8_SA(0, 0), cA, voffA); PG8_STAGE(PG8_SA(0, 1), cA + hstepA, voffA);
    if (wr == 1) PG8_BAR;
    PG8_WAIT_V(2); PG8_BAR;
    PG8_STAGE(PG8_SB(1, 0), cB + kstep, voffB); PG8_STAGE(PG8_SA(1, 0), cA + kstep, voffA); PG8_STAGE(PG8_SB(1, 1), cB + hstepB + kstep, voffB);
    PG8_WAIT_V(6); PG8_BAR;
    for (;;) {
        const bool has_next = S.next(ui + 1, nxt);
        const char* nA = has_next ? (const char*)g.A + (size_t)nxt.z * g.zA * 2 + (size_t)nxt.pm * 2 * hstepA + (nxt.pn >= g.pn_split ? (size_t)g.a_off2 * 2 : (size_t)0) : cA;
        const char* nB = has_next ? (const char*)g.Bt + (size_t)nxt.z * g.zB * 2 + (size_t)nxt.pn * 2 * hstepB : cB;
#pragma clang loop unroll(disable)
        for (int t = 0; t < nt; t += 2) {
            const bool last = (t == nt - 2);
            const char* a1 = cA + (size_t)(t + 1) * kstep;
            const char* a2 = last ? nA : cA + (size_t)(t + 2) * kstep; const char* b2 = last ? nB : cB + (size_t)(t + 2) * kstep;
            const char* a3 = a2 + kstep; const char* b3 = b2 + kstep;
            PG8_LDB(B0, 0, 0); PG8_LDB(B1, 0, 1); PG8_SCHED; PG8_LDA(At, 0, 0); PG8_STAGE(PG8_SA(1, 1), a1 + hstepA, voffA);
            PG8_WAIT_V(8); PG8_WAIT_L(0); PG8_BAR; PG8_MMA(0, 0, At, B0); PG8_MMA(0, 1, At, B1); PG8_BAR; PG8_SCHED;
            PG8_LDA(At, 0, 1); PG8_STAGE(PG8_SB(0, 0), b2, voffB); PG8_STAGE(PG8_SB(0, 1), b2 + hstepB, voffB); PG8_STAGE(PG8_SA(0, 0), a2, voffA);
            PG8_WAIT_V(8); PG8_WAIT_L(0); PG8_BAR; PG8_MMA(1, 0, At, B0); PG8_MMA(1, 1, At, B1); PG8_BAR; PG8_SCHED;
            PG8_LDB(B0, 1, 0); PG8_LDB(B1, 1, 1); PG8_SCHED; PG8_LDA(At, 1, 0); PG8_STAGE(PG8_SA(0, 1), a2 + hstepA, voffA);
            PG8_WAIT_V(8); PG8_WAIT_L(0); PG8_BAR; PG8_MMA(0, 0, At, B0); PG8_MMA(0, 1, At, B1); PG8_BAR; PG8_SCHED;
            PG8_LDA(At, 1, 1); PG8_STAGE(PG8_SB(1, 0), b3, voffB); PG8_STAGE(PG8_SB(1, 1), b3 + hstepB, voffB); PG8_STAGE(PG8_SA(1, 0), a3, voffA);
            PG8_WAIT_V(8); PG8_WAIT_L(0); PG8_BAR; PG8_MMA(1, 0, At, B0); PG8_MMA(1, 1, At, B1); PG8_BAR; PG8_SCHED;
        }
        if (wr == 0) PG8_BAR;
        E(acc, cur, wr, wc, fr, fq);
        if (!has_next) break;
#pragma unroll
        for (int a = 0; a < 2; ++a)
#pragma unroll
            for (int b = 0; b < 2; ++b)
#pragma unroll
                for (int m = 0; m < 4; ++m)
#pragma unroll
                    for (int n = 0; n < 2; ++n) acc[a][b][m][n] = (f32x4){0.f, 0.f, 0.f, 0.f};
        cur = nxt; cA = nA; cB = nB; ++ui;
        if (wr == 1) PG8_BAR;
    }
    PG8_WAIT_V(0);
    PG8_BAR;
#undef PG8_SA
#undef PG8_SB
#undef PG8_STAGE
#undef PG8_LDA
#undef PG8_LDB
#undef PG8_MMA
#undef PG8_WAIT_V
#undef PG8_WAIT_L
#undef PG8_BAR
#undef PG8_SCHED
}

struct EpiProj {
    static constexpr bool PERM = true;
    bf16_t* proj; float* small;
    DI void operator()(const f32x4 (&acc)[2][2][4][2], const Unit& u, int wr, int wc, int fr, int fq) const {
        const int row0 = u.pm * BM + wr * 64 + fr, colb = u.pn * BM + wc * 32 + 8 * fq;
#pragma unroll
        for (int ai = 0; ai < 2; ++ai)
#pragma unroll
            for (int m = 0; m < 4; ++m) { const size_t row = (size_t)(row0 + ai * HALF + m * 16);
#pragma unroll
                for (int bj = 0; bj < 2; ++bj) { const int col = colb + bj * HALF; const f32x4 v0 = acc[ai][bj][m][0], v1 = acc[ai][bj][m][1];
                    if (col < PLD) { u32x4 o; o[0] = pk2(v0[0], v0[1]); o[1] = pk2(v0[2], v0[3]); o[2] = pk2(v1[0], v1[1]); o[3] = pk2(v1[2], v1[3]); *(u32x4*)(proj + row * PLD + col) = o; }
                    else if (col < PLD + 16) { float* sp = small + row * 16 + (col - PLD); *(f32x4*)sp = v0; *(f32x4*)(sp + 4) = v1; } } }
    }
};
template <int ACT> struct EpiBf16 {
    static constexpr bool PERM = true;
    bf16_t* O; int ldc; int zc;
    DI void operator()(const f32x4 (&acc)[2][2][4][2], const Unit& u, int wr, int wc, int fr, int fq) const {
        const int row0 = u.pm * BM + wr * 64 + fr, colb = u.z * zc + u.pn * BM + wc * 32 + 8 * fq;
#pragma unroll
        for (int ai = 0; ai < 2; ++ai)
#pragma unroll
            for (int m = 0; m < 4; ++m) { const size_t row = (size_t)(row0 + ai * HALF + m * 16);
#pragma unroll
                for (int bj = 0; bj < 2; ++bj) { f32x4 v0 = acc[ai][bj][m][0], v1 = acc[ai][bj][m][1];
                    if (ACT == 1) {
#pragma unroll
                        for (int j = 0; j < 4; ++j) { const float a = fmaxf(v0[j], 0.f), b = fmaxf(v1[j], 0.f); v0[j] = a * a; v1[j] = b * b; } }
                    u32x4 o; o[0] = pk2(v0[0], v0[1]); o[1] = pk2(v0[2], v0[3]); o[2] = pk2(v1[0], v1[1]); o[3] = pk2(v1[2], v1[3]);
                    *(u32x4*)(O + row * ldc + colb + bj * HALF) = o; } }
    }
};
struct EpiResid {
    static constexpr bool PERM = false;
    float* dst; const float* src;
    DI void operator()(const f32x4 (&acc)[2][2][4][2], const Unit& u, int wr, int wc, int fr, int fq) const {
        const int row0 = u.pm * BM + wr * 64 + fr, col0 = u.pn * BM + wc * 32 + 4 * fq;
#pragma unroll
        for (int ai = 0; ai < 2; ++ai)
#pragma unroll
            for (int mp = 0; mp < 2; ++mp) {
                f32x4 sv[2][2][2];
#pragma unroll
                for (int mm = 0; mm < 2; ++mm)
#pragma unroll
                    for (int bj = 0; bj < 2; ++bj)
#pragma unroll
                        for (int n = 0; n < 2; ++n) sv[mm][bj][n] = *(const f32x4*)(src + (size_t)(row0 + ai * HALF + (2 * mp + mm) * 16) * 1024 + col0 + bj * HALF + n * 16);
                __builtin_amdgcn_sched_barrier(0);
#pragma unroll
                for (int mm = 0; mm < 2; ++mm)
#pragma unroll
                    for (int bj = 0; bj < 2; ++bj)
#pragma unroll
                        for (int n = 0; n < 2; ++n) *(f32x4*)(dst + (size_t)(row0 + ai * HALF + (2 * mp + mm) * 16) * 1024 + col0 + bj * HALF + n * 16) = sv[mm][bj][n] + acc[ai][bj][2 * mp + mm][n];
                __builtin_amdgcn_sched_barrier(0);
            }
    }
};
struct EpiMerge {
    static constexpr bool PERM = false;
    const bf16_t* P; bf16_t* merged;
    DI void operator()(const f32x4 (&acc)[2][2][4][2], const Unit& u, int wr, int wc, int fr, int fq) const {
        const int row0 = u.pm * BM + wr * 64 + fr, d0 = u.pn * 64 + wc * 16 + 4 * fq;
#pragma unroll
        for (int ai = 0; ai < 2; ++ai) {
            u32x2 pv[4][4];
#pragma unroll
            for (int m = 0; m < 4; ++m)
#pragma unroll
                for (int j = 0; j < 4; ++j) pv[m][j] = *(const u32x2*)(P + (size_t)(row0 + ai * HALF + m * 16) * 4096 + j * 1024 + d0);
            __builtin_amdgcn_sched_barrier(0);
#pragma unroll
            for (int m = 0; m < 4; ++m) { const size_t row = (size_t)(row0 + ai * HALF + m * 16);
                float o[4] = {0.f, 0.f, 0.f, 0.f};
#pragma unroll
                for (int j = 0; j < 4; ++j) { const u32x2 pw = pv[m][j];
                    const float p0 = __uint_as_float(pw[0] << 16), p1 = __uint_as_float(pw[0] & 0xffff0000u), p2 = __uint_as_float(pw[1] << 16), p3 = __uint_as_float(pw[1] & 0xffff0000u);
                    o[0] += sigmoidf_(acc[ai][0][m][0][j]) * p0; o[1] += sigmoidf_(acc[ai][0][m][1][j]) * p1;
                    o[2] += sigmoidf_(acc[ai][1][m][0][j]) * p2; o[3] += sigmoidf_(acc[ai][1][m][1][j]) * p3; }
                u32x2 ov; ov[0] = pk2(o[0], o[1]); ov[1] = pk2(o[2], o[3]);
                *(u32x2*)(merged + row * 1024 + d0) = ov; }
            __builtin_amdgcn_sched_barrier(0);
        }
    }
};
}

template <class F>
DI void convert_mat(bf16_t* dst, int N, int Kd, F elem, float* tl, const int tid) {
    const int ntn = N / 64, ntk = Kd / 64, nt = ntn * ntk;
    float v[8];
    int tile = blockIdx.x;
    if (tile < nt) { const int tn = tile % ntn, tk = tile / ntn;
#pragma unroll
        for (int e = 0; e < 8; ++e) { const int idx = tid + e * NTHR; v[e] = elem(tn * 64 + (idx & 63), tk * 64 + (idx >> 6)); } }
    for (; tile < nt; tile += gridDim.x) {
        const int tn = tile % ntn, tk = tile / ntn;
        __syncthreads();
#pragma unroll
        for (int e = 0; e < 8; ++e) { const int idx = tid + e * NTHR; tl[(idx >> 6) * 65 + (idx & 63)] = v[e]; }
        __syncthreads();
        { const int nx = tile + gridDim.x; if (nx < nt) { const int tn2 = nx % ntn, tk2 = nx / ntn;
#pragma unroll
            for (int e = 0; e < 8; ++e) { const int idx = tid + e * NTHR; v[e] = elem(tn2 * 64 + (idx & 63), tk2 * 64 + (idx >> 6)); } } }
#pragma unroll
        for (int e = 0; e < 4; ++e) { const int idx = tid + e * NTHR; const int n = idx >> 5, k2 = (idx & 31) * 2;
            *(unsigned*)(dst + (size_t)(tn * 64 + n) * Kd + tk * 64 + k2) = pk2(tl[k2 * 65 + n], tl[(k2 + 1) * 65 + n]); }
    }
}

DI void rmsnorm_phase(const float* x, const float* g, bf16_t* h, int ntok, const int tid) {
    const int lane = tid & 63, wv = tid >> 6;
    f32x4 gg[4];
#pragma unroll
    for (int c = 0; c < 4; ++c) gg[c] = ((const f32x4*)g)[lane + 64 * c];
    for (int t0 = (blockIdx.x * 8 + wv) * 2; t0 < ntok; t0 += gridDim.x * 16) {
        f32x4 v[2][4];
#pragma unroll
        for (int u = 0; u < 2; ++u)
#pragma unroll
            for (int c = 0; c < 4; ++c) v[u][c] = ((const f32x4*)(x + (size_t)(t0 + u) * 1024))[lane + 64 * c];
#pragma unroll
        for (int u = 0; u < 2; ++u) { float ss = 0.f;
#pragma unroll
            for (int c = 0; c < 4; ++c) ss += v[u][c][0] * v[u][c][0] + v[u][c][1] * v[u][c][1] + v[u][c][2] * v[u][c][2] + v[u][c][3] * v[u][c][3];
            ss = wave_sum(ss);
            const float rs = rsqrtf(ss * (1.f / 1024.f) + NEPS);
#pragma unroll
            for (int c = 0; c < 4; ++c) { u32x2 o; o[0] = pk2(v[u][c][0] * rs * gg[c][0], v[u][c][1] * rs * gg[c][1]); o[1] = pk2(v[u][c][2] * rs * gg[c][2], v[u][c][3] * rs * gg[c][3]);
                *(u32x2*)(h + (size_t)(t0 + u) * 1024 + (lane + 64 * c) * 4) = o; } }
    }
}

DI void transpose_v_item(const bf16_t* src, int ld, bf16_t* vt, int s0, bf16_t* ts  , const int tid) {
    __syncthreads();
    { const int row = tid >> 3, seg = tid & 7; const u32x4 a = *(const u32x4*)(src + (size_t)row * ld + seg * 16), b = *(const u32x4*)(src + (size_t)row * ld + seg * 16 + 8);
      unsigned* d = (unsigned*)(ts + row * 130 + seg * 16);
      d[0] = a[0]; d[1] = a[1]; d[2] = a[2]; d[3] = a[3]; d[4] = b[0]; d[5] = b[1]; d[6] = b[2]; d[7] = b[3]; }
    __syncthreads();
    { const int dv = tid >> 2, part = tid & 3; u32x4 o0, o1;
#pragma unroll
      for (int e = 0; e < 4; ++e) { o0[e] = (unsigned)ts[(part * 16 + 2 * e) * 130 + dv] | ((unsigned)ts[(part * 16 + 2 * e + 1) * 130 + dv] << 16);
                                    o1[e] = (unsigned)ts[(part * 16 + 8 + 2 * e) * 130 + dv] | ((unsigned)ts[(part * 16 + 8 + 2 * e + 1) * 130 + dv] << 16); }
      bf16_t* d = vt + (size_t)dv * SEQ + s0 + part * 16; *(u32x4*)d = o0; *(u32x4*)(d + 8) = o1; }
}

DI void transpose_v_phase(const bf16_t* base, int ld, int col0, int colh, bf16_t* vtbase, bf16_t* ts  , const int tid) {
    const int row = tid >> 3, seg = tid & 7, dv = tid >> 2, part = tid & 3;
    int it = blockIdx.x; u32x4 pa, pb;
    if (it < 2048) { const int sti = it & 63, h = (it >> 6) & 3, b = it >> 8; const bf16_t* src = base + (size_t)(b * SEQ + sti * 64 + row) * ld + col0 + h * colh + seg * 16;
        pa = *(const u32x4*)src; pb = *(const u32x4*)(src + 8); }
    for (; it < 2048; it += gridDim.x) {
        const int sti = it & 63, h = (it >> 6) & 3, b = it >> 8;
        __syncthreads();
        { unsigned* d = (unsigned*)(ts + row * 130 + seg * 16); d[0] = pa[0]; d[1] = pa[1]; d[2] = pa[2]; d[3] = pa[3]; d[4] = pb[0]; d[5] = pb[1]; d[6] = pb[2]; d[7] = pb[3]; }
        __syncthreads();
        { const int nx = it + gridDim.x; if (nx < 2048) { const int sti2 = nx & 63, h2 = (nx >> 6) & 3, b2 = nx >> 8; const bf16_t* src = base + (size_t)(b2 * SEQ + sti2 * 64 + row) * ld + col0 + h2 * colh + seg * 16;
            pa = *(const u32x4*)src; pb = *(const u32x4*)(src + 8); } }
        u32x4 o0, o1;
#pragma unroll
        for (int e = 0; e < 4; ++e) { o0[e] = (unsigned)ts[(part * 16 + 2 * e) * 130 + dv] | ((unsigned)ts[(part * 16 + 2 * e + 1) * 130 + dv] << 16);
                                      o1[e] = (unsigned)ts[(part * 16 + 8 + 2 * e) * 130 + dv] | ((unsigned)ts[(part * 16 + 8 + 2 * e + 1) * 130 + dv] << 16); }
        bf16_t* d = vtbase + (size_t)(b * 4 + h) * 128 * SEQ + (size_t)dv * SEQ + sti * 64 + part * 16; *(u32x4*)d = o0; *(u32x4*)(d + 8) = o1;
    }
}

struct DnPrepArgs { const bf16_t* proj; const float* small; const float* convw; const float* alog; const float* dtb;
                    bf16_t *qdec, *negw, *u, *kdT, *aqk; float* glast; };
DI void dn_prep_item(int item, const DnPrepArgs& a, unsigned char* smem, const int tid, const int lim = 9) {
    const int lane = tid & 63, wv = tid >> 6;
    const int bh = item >> 6, n = item & 63, b = bh >> 2, h = bh & 3;
    const int t0 = b * SEQ + n * 64, s0 = n * 64;
    bf16_t* RT = (bf16_t*)smem;
    float* R1 = (float*)(smem + 36864);
    bf16_t* qs = (bf16_t*)(smem + 69632);
    bf16_t* ks = (bf16_t*)(smem + 87040);
    float* Lm = (float*)(smem + 104448);
    float* Tm = (float*)(smem + 121856);
    float* tmp = (float*)(smem + 139264);
    bf16_t* Tb = (bf16_t*)(smem + 143488);
    float* gcs = (float*)(smem + 152704); float* betas = gcs + 64; float* egs = gcs + 128;
    float xr[3][19];
    { const int seg = tid >> 7, c = tid & 127, tt0 = seg * 16;
#pragma unroll
      for (int part = 0; part < 3; ++part) { const bf16_t* src = a.proj + (size_t)t0 * PLD + part * 512 + h * 128 + c;
#pragma unroll
          for (int e = 0; e < 19; ++e) { const int ti = tt0 + e - 3; const bool ok = (s0 + ti >= 0); const float vv = bf2f(src[(long)(ok ? ti : 0) * PLD]); xr[part][e] = ok ? vv : 0.f; } } }
    __syncthreads();
    if (tid < 64) {
        const float al = a.small[(size_t)(t0 + tid) * 16 + h], bl = a.small[(size_t)(t0 + tid) * 16 + 4 + h];
        const float xx = al + a.dtb[h]; const float sp = xx > 20.f ? xx : log1pf(__expf(xx));
        float g = -__expf(a.alog[h]) * sp;
        for (int o = 1; o < 64; o <<= 1) { const float t = __shfl_up(g, o); if (lane >= o) g += t; }
        gcs[tid] = g; betas[tid] = sigmoidf_(bl); egs[tid] = __expf(g);
    }
    for (int e = tid; e < 64 * 68; e += NTHR) Tm[e] = 0.f;
    __syncthreads();
    {
        const int seg = tid >> 7, c = tid & 127, tt0 = seg * 16;
        float y[3][16];
#pragma unroll
        for (int part = 0; part < 3; ++part) { const int col = part * 512 + h * 128 + c;
            const float w0 = a.convw[col], w1 = a.convw[1536 + col], w2 = a.convw[2 * 1536 + col], w3 = a.convw[3 * 1536 + col];
#pragma unroll
            for (int e = 0; e < 16; ++e) y[part][e] = siluf_(w0 * xr[part][e] + w1 * xr[part][e + 1] + w2 * xr[part][e + 2] + w3 * xr[part][e + 3]); }
        float* ssq = R1;
#pragma unroll
        for (int part = 0; part < 2; ++part) {
            float v[16];
#pragma unroll
            for (int e = 0; e < 16; ++e) v[e] = y[part][e] * y[part][e];
#define TR_STEP(o, n) { const bool up = (lane & (o)) != 0; _Pragma("unroll") for (int i = 0; i < (n) / 2; ++i) { const float av = v[i], bv = v[i + (n) / 2]; const float snd = up ? av : bv, kp = up ? bv : av; v[i] = kp + __shfl_xor(snd, (o)); } }
            TR_STEP(1, 16) TR_STEP(2, 8) TR_STEP(4, 4) TR_STEP(8, 2)
#undef TR_STEP
            float tot = v[0]; tot += __shfl_xor(tot, 16); tot += __shfl_xor(tot, 32);
            if (lane < 16) { const int e = ((lane & 1) << 3) | ((lane & 2) << 1) | ((lane & 4) >> 1) | ((lane & 8) >> 3); ssq[(part * 64 + tt0 + e) * 2 + (wv & 1)] = tot; }
        }
        __syncthreads();
        float rk_[16], rv_[16];
#pragma unroll
        for (int e = 0; e < 16; ++e) { const int tt = tt0 + e;
            const float rq = rsqrtf(ssq[tt * 2] + ssq[tt * 2 + 1] + NEPS) * 0.08838834764831845f, rk = rsqrtf(ssq[(64 + tt) * 2] + ssq[(64 + tt) * 2 + 1] + NEPS);
            const float bt = betas[tt];
            qs[tt * 136 + c] = f2bf(y[0][e] * rq);
            const float kn = y[1][e] * rk; ks[tt * 136 + c] = f2bf(kn);
            rk_[e] = kn * bt * egs[tt]; rv_[e] = y[2][e] * bt; }
        u32x4 o0, o1;
#pragma unroll
        for (int e = 0; e < 4; ++e) { o0[e] = pk2(rk_[2 * e], rk_[2 * e + 1]); o1[e] = pk2(rk_[8 + 2 * e], rk_[8 + 2 * e + 1]); }
        *(u32x4*)(RT + (128 + c) * 72 + tt0) = o0; *(u32x4*)(RT + (128 + c) * 72 + tt0 + 8) = o1;
#pragma unroll
        for (int e = 0; e < 4; ++e) { o0[e] = pk2(rv_[2 * e], rv_[2 * e + 1]); o1[e] = pk2(rv_[8 + 2 * e], rv_[8 + 2 * e + 1]); }
        *(u32x4*)(RT + c * 72 + tt0) = o0; *(u32x4*)(RT + c * 72 + tt0 + 8) = o1;
    }
    __syncthreads();
    if (lim <= 1) return;
    {
        const int r = lane & 31, h2 = lane >> 5, w4 = wv & 3, ib = w4 >> 1, jb = w4 & 1;
        const bf16_t* Am = (wv < 4) ? ks : qs;
        f32x16 acc; for (int i = 0; i < 16; ++i) acc[i] = 0.f;
#pragma unroll
        for (int s = 0; s < 8; ++s) { const bf16x8 av = *(const bf16x8*)(Am + (32 * ib + r) * 136 + 16 * s + 8 * h2), bv = *(const bf16x8*)(ks + (32 * jb + r) * 136 + 16 * s + 8 * h2);
            acc = MFMA32(av, bv, acc); }
        const int j = 32 * jb + r; const float gj = gcs[j];
        bf16_t* aq = a.aqk + (size_t)item * 4096;
#pragma unroll
        for (int i2 = 0; i2 < 16; ++i2) { const int i = 32 * ib + crow(i2, h2); const float gi = gcs[i];
            if (wv < 4) { Lm[i * 68 + j] = (j < i) ? betas[i] * acc[i2] * __expf(gi - gj) : 0.f; }
            else { aq[i * 64 + j] = f2bf((j <= i) ? acc[i2] * __expf(gi - gj) : 0.f); } }
    }
    __syncthreads();
    if (lim <= 2) return;
    if (tid < 64) { const int ab = tid >> 4, c = tid & 15; float x[16];
#pragma unroll
        for (int i = 0; i < 16; ++i) { float sv = (i == c) ? 1.f : 0.f;
#pragma unroll
            for (int jx = 0; jx < i; ++jx) sv -= Lm[(16 * ab + i) * 68 + 16 * ab + jx] * x[jx];
            x[i] = sv; }
#pragma unroll
        for (int i = 0; i < 16; ++i) Tm[(16 * ab + i) * 68 + 16 * ab + c] = x[i]; }
    __syncthreads();
    { const int pp = tid >> 8, i = (tid >> 4) & 15, jx = tid & 15; float sv = 0.f;
#pragma unroll
      for (int k = 0; k < 16; ++k) sv += Lm[(32 * pp + 16 + i) * 68 + 32 * pp + k] * Tm[(32 * pp + k) * 68 + 32 * pp + jx];
      tmp[(pp * 16 + i) * 33 + jx] = sv; }
    __syncthreads();
    { const int pp = tid >> 8, i = (tid >> 4) & 15, jx = tid & 15; float sv = 0.f;
#pragma unroll
      for (int k = 0; k < 16; ++k) sv += Tm[(32 * pp + 16 + i) * 68 + 32 * pp + 16 + k] * tmp[(pp * 16 + k) * 33 + jx];
      __syncthreads();
      Tm[(32 * pp + 16 + i) * 68 + 32 * pp + jx] = -sv; }
    __syncthreads();
    { const int i = tid >> 4, j0 = (tid & 15) * 2; float s0v = 0.f, s1v = 0.f;
#pragma unroll 8
      for (int k = 0; k < 32; ++k) { const float lv = Lm[(32 + i) * 68 + k]; s0v += lv * Tm[k * 68 + j0]; s1v += lv * Tm[k * 68 + j0 + 1]; }
      tmp[i * 33 + j0] = s0v; tmp[i * 33 + j0 + 1] = s1v; }
    __syncthreads();
    { const int i = tid >> 4, j0 = (tid & 15) * 2; float s0v = 0.f, s1v = 0.f;
#pragma unroll 8
      for (int k = 0; k < 32; ++k) { const float tv = Tm[(32 + i) * 68 + 32 + k]; s0v += tv * tmp[k * 33 + j0]; s1v += tv * tmp[k * 33 + j0 + 1]; }
      Tm[(32 + i) * 68 + j0] = -s0v; Tm[(32 + i) * 68 + j0 + 1] = -s1v; }
    __syncthreads();
#pragma unroll
    for (int e = 0; e < 8; ++e) { const int idx = tid + e * NTHR, i = idx >> 6, jx = idx & 63; Tb[i * 72 + jx] = f2bf(Tm[i * 68 + jx]); }
    __syncthreads();
    if (lim <= 3) return;
    {
        const int r = lane & 31, h2 = lane >> 5;
#pragma unroll
        for (int ib = 0; ib < 2; ++ib) {
            f32x16 acc; for (int i = 0; i < 16; ++i) acc[i] = 0.f;
#pragma unroll
            for (int s = 0; s < 4; ++s) acc = MFMA32(*(const bf16x8*)(Tb + (32 * ib + r) * 72 + 16 * s + 8 * h2), *(const bf16x8*)(RT + (32 * wv + r) * 72 + 16 * s + 8 * h2), acc);
            bf16_t* dst = ((wv < 4) ? a.u : a.negw) + (size_t)item * 8192 + 32 * (wv & 3) + r; const float sg = (wv < 4) ? 1.f : -1.f;
#pragma unroll
            for (int i2 = 0; i2 < 16; ++i2) dst[(32 * ib + crow(i2, h2)) * 128] = f2bf(sg * acc[i2]);
        }
    }
    {
        const int tt = tid >> 3, seg = tid & 7; const float eg = __expf(gcs[tt]);
        u32x4 o0, o1;
        const bf16_t* qr = qs + tt * 136 + seg * 16;
#pragma unroll
        for (int e = 0; e < 4; ++e) { o0[e] = pk2(bf2f(qr[2 * e]) * eg, bf2f(qr[2 * e + 1]) * eg); o1[e] = pk2(bf2f(qr[8 + 2 * e]) * eg, bf2f(qr[8 + 2 * e + 1]) * eg); }
        bf16_t* d = a.qdec + (size_t)item * 8192 + tt * 128 + seg * 16; *(u32x4*)d = o0; *(u32x4*)(d + 8) = o1;
        const int dk = tid >> 2, part = tid & 3; const float gl = gcs[63];
#pragma unroll
        for (int e = 0; e < 4; ++e) { const int ta = part * 16 + 2 * e, tb = part * 16 + 8 + 2 * e;
            o0[e] = pk2(bf2f(ks[ta * 136 + dk]) * __expf(gl - gcs[ta]), bf2f(ks[(ta + 1) * 136 + dk]) * __expf(gl - gcs[ta + 1]));
            o1[e] = pk2(bf2f(ks[tb * 136 + dk]) * __expf(gl - gcs[tb]), bf2f(ks[(tb + 1) * 136 + dk]) * __expf(gl - gcs[tb + 1])); }
        d = a.kdT + (size_t)item * 8192 + dk * 64 + part * 16; *(u32x4*)d = o0; *(u32x4*)(d + 8) = o1;
        if (tid == 0) a.glast[item] = __expf(gl);
    }
}

struct DnScanArgs { const bf16_t *qdec, *negw, *u, *kdT, *aqk; const float* glast; bf16_t* obuf; const bf16_t* proj; const float* og; };
DI void dn_scan_item(int bh, const DnScanArgs& a, unsigned char* smem, const int tid) {
    const int lane = tid & 63, wv = tid >> 6, r = lane & 31, h2 = lane >> 5;
    const int b = bh >> 2, h = bh & 3;
    constexpr int BUFB = (3 * 64 * 136 + 64 * 72 + 128 * 72) * 2;
    __syncthreads();
#define DN_LOAD(n_) do { const size_t item_ = (size_t)bh * 64 + (n_); bf16_t* sW_ = (bf16_t*)(smem + ((n_) & 1) * BUFB); bf16_t* sQ_ = sW_ + 64 * 136; bf16_t* sU_ = sQ_ + 64 * 136; bf16_t* sA_ = sU_ + 64 * 136; bf16_t* sK_ = sA_ + 64 * 72; \
        const int lt_ = tid - 256; u32x4 w_[4], q_[4], u_[4], k_[4], a_[2]; \
        _Pragma("unroll") for (int i = 0; i < 4; ++i) { const int c = lt_ + 256 * i; const size_t o = item_ * 8192 + (size_t)(c >> 4) * 128 + (c & 15) * 8; \
            w_[i] = *(const u32x4*)(a.negw + o); q_[i] = *(const u32x4*)(a.qdec + o); u_[i] = *(const u32x4*)(a.u + o); k_[i] = *(const u32x4*)(a.kdT + item_ * 8192 + (size_t)(c >> 3) * 64 + (c & 7) * 8); } \
        _Pragma("unroll") for (int i = 0; i < 2; ++i) { const int c = lt_ + 256 * i; a_[i] = *(const u32x4*)(a.aqk + item_ * 4096 + (size_t)(c >> 3) * 64 + (c & 7) * 8); } \
        _Pragma("unroll") for (int i = 0; i < 4; ++i) { const int c = lt_ + 256 * i; const int o = (c >> 4) * 136 + (c & 15) * 8; \
            *(u32x4*)(sW_ + o) = w_[i]; *(u32x4*)(sQ_ + o) = q_[i]; *(u32x4*)(sU_ + o) = u_[i]; *(u32x4*)(sK_ + (c >> 3) * 72 + (c & 7) * 8) = k_[i]; } \
        _Pragma("unroll") for (int i = 0; i < 2; ++i) { const int c = lt_ + 256 * i; *(u32x4*)(sA_ + (c >> 3) * 72 + (c & 7) * 8) = a_[i]; } } while (0)
    if (wv >= 4) DN_LOAD(0);
    __syncthreads();
    if (wv >= 4) {
        const float og0 = a.og[2 * lane], og1 = a.og[2 * lane + 1];
#define DN_POST(c_) do { const size_t row0_ = (size_t)b * SEQ + (size_t)(c_) * 64 + (wv - 4) * 16; unsigned vo_[16], vz_[16]; \
        _Pragma("unroll") for (int e = 0; e < 16; ++e) { vo_[e] = *(const unsigned*)(a.obuf + (row0_ + e) * 2048 + h * 128 + 2 * lane); vz_[e] = *(const unsigned*)(a.proj + (row0_ + e) * PLD + 1536 + h * 128 + 2 * lane); } \
        _Pragma("unroll") for (int e = 0; e < 16; ++e) { const float a0 = __uint_as_float(vo_[e] << 16), a1 = __uint_as_float(vo_[e] & 0xffff0000u); \
            const float rs = rsqrtf(wave_sum(a0 * a0 + a1 * a1) * (1.f / 128.f) + NEPS); const float z0 = __uint_as_float(vz_[e] << 16), z1 = __uint_as_float(vz_[e] & 0xffff0000u); \
            *(unsigned*)(a.obuf + (row0_ + e) * 2048 + h * 128 + 2 * lane) = pk2(a0 * rs * og0 * siluf_(z0), a1 * rs * og1 * siluf_(z1)); } } while (0)
        for (int n = 0; n < 64; ++n) { if (n + 1 < 64) DN_LOAD(n + 1); if (n >= 1) DN_POST(n - 1); __syncthreads(); }
        DN_POST(63);
#undef DN_POST
    } else {
        f32x16 S[4];
#pragma unroll
        for (int k = 0; k < 4; ++k) for (int i = 0; i < 16; ++i) S[k][i] = 0.f;
        bf16x8 If[2];
#pragma unroll
        for (int s = 0; s < 2; ++s) for (int j = 0; j < 8; ++j) If[s][j] = ((16 * s + 8 * (j >> 2) + 4 * h2 + (j & 3)) == r) ? (short)0x3F80 : (short)0;
        float gl_next = a.glast[(size_t)bh * 64];
        for (int n = 0; n < 64; ++n) {
            const float gl = gl_next; gl_next = a.glast[(size_t)bh * 64 + ((n + 1 < 64) ? n + 1 : n)];
            const bf16_t* sW = (const bf16_t*)(smem + (n & 1) * BUFB); const bf16_t* sQ = sW + 64 * 136; const bf16_t* sU = sQ + 64 * 136; const bf16_t* sA = sU + 64 * 136; const bf16_t* sK = sA + 64 * 72;
            bf16x8 Sf[4][2];
#pragma unroll
            for (int kb = 0; kb < 4; ++kb) { Sf[kb][0] = pack8(S[kb], 0); Sf[kb][1] = pack8(S[kb], 1); }
            bf16x8 Vf[2][2];
#pragma unroll
            for (int tb = 0; tb < 2; ++tb) {
                f32x16 acc; for (int i = 0; i < 16; ++i) acc[i] = 0.f;
#pragma unroll
                for (int kb = 0; kb < 4; ++kb)
#pragma unroll
                    for (int s = 0; s < 2; ++s) acc = MFMA32(ld_perm(sW + (32 * tb + r) * 136 + 32 * kb + 16 * s + 4 * h2), Sf[kb][s], acc);
#pragma unroll
                for (int s = 0; s < 2; ++s) acc = MFMA32(ld_perm(sU + (32 * tb + r) * 136 + 32 * wv + 16 * s + 4 * h2), If[s], acc);
                Vf[tb][0] = pack8(acc, 0); Vf[tb][1] = pack8(acc, 1);
            }
#pragma unroll
            for (int ib = 0; ib < 2; ++ib) {
                f32x16 acc; for (int i = 0; i < 16; ++i) acc[i] = 0.f;
#pragma unroll
                for (int kb = 0; kb < 4; ++kb)
#pragma unroll
                    for (int s = 0; s < 2; ++s) acc = MFMA32(ld_perm(sQ + (32 * ib + r) * 136 + 32 * kb + 16 * s + 4 * h2), Sf[kb][s], acc);
#pragma unroll
                for (int tb = 0; tb < 2; ++tb)
#pragma unroll
                    for (int s = 0; s < 2; ++s) acc = MFMA32(ld_perm(sA + (32 * ib + r) * 72 + 32 * tb + 16 * s + 4 * h2), Vf[tb][s], acc);
                bf16_t* op = a.obuf + (size_t)(b * SEQ + n * 64 + 32 * ib) * 2048 + h * 128 + 32 * wv + r;
#pragma unroll
                for (int i = 0; i < 16; ++i) op[(size_t)crow(i, h2) * 2048] = f2bf(acc[i]);
            }
#pragma unroll
            for (int kb = 0; kb < 4; ++kb) {
                f32x16 acc = S[kb];
#pragma unroll
                for (int i = 0; i < 16; ++i) acc[i] *= gl;
#pragma unroll
                for (int tb = 0; tb < 2; ++tb)
#pragma unroll
                    for (int s = 0; s < 2; ++s) acc = MFMA32(ld_perm(sK + (32 * kb + r) * 72 + 32 * tb + 16 * s + 4 * h2), Vf[tb][s], acc);
                S[kb] = acc;
            }
            __syncthreads();
        }
    }
#undef DN_LOAD
}

template <int DK, bool DECAY>
DI void attn_item(const bf16_t* Q, int ldq, const bf16_t* Kp, int ldk, const bf16_t* Vt, const float* cum, bf16_t* O, int ldo, int qt, float m0, unsigned char* smem, const int tid, const int rep = 0) {
    const int amode = rep ? PROBE_SUB : 0;
    constexpr int KLD = DK + 8, NKC = DK / 8, NKL = (64 * NKC) / NTHR, KS = DK / 16, VLD = 68;
    constexpr int STAGE = 64 * KLD * 2 + 128 * VLD * 2 + 256;
    const int lane = tid & 63, wv = tid >> 6, r = lane & 31, h2 = lane >> 5;
    const int q0 = qt * 256 + wv * 32;
    bf16x8 qf[KS];
#pragma unroll
    for (int ks = 0; ks < KS; ++ks) qf[ks] = *(const bf16x8*)(Q + (size_t)(q0 + r) * ldq + 16 * ks + 8 * h2);
    f32x16 oacc[4];
#pragma unroll
    for (int d = 0; d < 4; ++d) for (int i = 0; i < 16; ++i) oacc[d][i] = 0.f;
    float l_run = 0.f;
    const float c0 = (DECAY ? cum[q0 + r] * LOG2E : 0.f) - m0;
    const int ntiles = (qt + 1) * 4;
    u32x4 pk_[NKL], pv_[2]; float pc_ = 0.f;
#define ATT_ISSUE_K(j_) do { const int k0_ = (j_) * 64; \
        _Pragma("unroll") for (int i = 0; i < NKL; ++i) { const int c = tid + i * NTHR, row = c / NKC, cc = c % NKC; pk_[i] = *(const u32x4*)(Kp + (size_t)(k0_ + row) * ldk + cc * 8); } \
        if (DECAY && tid < 64) pc_ = cum[k0_ + tid] * LOG2E; } while (0)
#define ATT_ISSUE_V(j_) do { const int k0_ = (j_) * 64; \
        _Pragma("unroll") for (int i = 0; i < 2; ++i) { const int c = tid + i * NTHR, row = c >> 3, cc = c & 7; pv_[i] = *(const u32x4*)(Vt + (size_t)row * SEQ + k0_ + cc * 8); } } while (0)
#define ATT_ISSUE(j_) do { ATT_ISSUE_K(j_); ATT_ISSUE_V(j_); } while (0)
    __syncthreads();
    ATT_ISSUE(0);
    for (int j = 0; j < ntiles; ++j) {
        unsigned char* st = smem + (j & 1) * STAGE;
        bf16_t* Ks = (bf16_t*)st; bf16_t* Vs = (bf16_t*)(st + 64 * KLD * 2); float* cks = (float*)(st + 64 * KLD * 2 + 128 * VLD * 2);
        if (amode != 5 || j == 0) {
#pragma unroll
        for (int i = 0; i < NKL; ++i) { const int c = tid + i * NTHR, row = c / NKC, cc = c % NKC; *(u32x4*)(Ks + row * KLD + cc * 8) = pk_[i]; }
#pragma unroll
        for (int i = 0; i < 2; ++i) { const int c = tid + i * NTHR, row = c >> 3, cc = c & 7; u32x2 lo, hi; lo[0] = pv_[i][0]; lo[1] = pv_[i][1]; hi[0] = pv_[i][2]; hi[1] = pv_[i][3];
            *(u32x2*)(Vs + row * VLD + cc * 8) = lo; *(u32x2*)(Vs + row * VLD + cc * 8 + 4) = hi; }
        if (DECAY && tid < 64) cks[tid] = pc_;
        }
        __syncthreads();
        const int k0 = j * 64;
        const bool active = (k0 <= q0 + 31) && (amode != 4);
        f32x16 sacc[2];
        if (active) {
#pragma unroll
            for (int kb = 0; kb < 2; ++kb) {
                constexpr int NB = KS / 4;
                const bf16_t* kp = Ks + (32 * kb + r) * KLD + 8 * h2;
                bf16x8 kf[2][4];
#pragma unroll
                for (int e = 0; e < 4; ++e) kf[0][e] = *(const bf16x8*)(kp + 16 * e);
                f32x16 acc; for (int i = 0; i < 16; ++i) acc[i] = 0.f;
#pragma unroll
                for (int bb = 0; bb < NB; ++bb) {
                    if (bb + 1 < NB) {
#pragma unroll
                        for (int e = 0; e < 4; ++e) kf[(bb + 1) & 1][e] = *(const bf16x8*)(kp + 16 * (4 * (bb + 1) + e)); }
                    __builtin_amdgcn_sched_barrier(0);
#pragma unroll
                    for (int e = 0; e < 4; ++e) acc = MFMA32(kf[bb & 1][e], qf[4 * bb + e], acc);
                    __builtin_amdgcn_sched_barrier(0);
                }
                sacc[kb] = acc;
            }
        }
        if (j + 1 < ntiles && amode != 5) ATT_ISSUE_K(j + 1);
        if (active) {
            const bool masked = (k0 + 63 > q0); const int qpos = q0 + r;
#pragma unroll
            for (int kb = 0; kb < 2; ++kb) {
                bf16x8 vfa[2][2], vfb[2][2];
#pragma unroll
                for (int d = 0; d < 2; ++d) { vfa[d][0] = ld_perm(Vs + (32 * d + r) * VLD + 32 * kb + 4 * h2); vfa[d][1] = ld_perm(Vs + (32 * d + r) * VLD + 32 * kb + 16 + 4 * h2); }
                f32x4 c4[2];
                if (DECAY) {
#pragma unroll
                    for (int g = 0; g < 2; ++g) c4[g] = *(const f32x4*)(cks + 32 * kb + 8 * g + 4 * h2); }
                __builtin_amdgcn_sched_barrier(0);
                if (DECAY) {
#pragma unroll
                    for (int g = 0; g < 2; ++g)
#pragma unroll
                        for (int e = 0; e < 4; ++e) sacc[kb][4 * g + e] -= c4[g][e];
#pragma unroll
                    for (int g = 0; g < 2; ++g) c4[g] = *(const f32x4*)(cks + 32 * kb + 8 * (g + 2) + 4 * h2);
#pragma unroll
                    for (int g = 0; g < 2; ++g)
#pragma unroll
                        for (int e = 0; e < 4; ++e) sacc[kb][4 * (g + 2) + e] -= c4[g][e];
                }
                if (masked) {
#pragma unroll
                    for (int i = 0; i < 16; ++i) { if (k0 + 32 * kb + crow(i, h2) > qpos) sacc[kb][i] = -INFINITY; } }
                float rs = 0.f;
#pragma unroll
                for (int i = 0; i < 16; ++i) { const float pz = __builtin_amdgcn_exp2f(sacc[kb][i] + c0); sacc[kb][i] = pz; rs += pz; }
                l_run += rs;
                const bf16x8 pf0 = pack8(sacc[kb], 0), pf1 = pack8(sacc[kb], 1);
                __builtin_amdgcn_sched_barrier(0);
#pragma unroll
                for (int d = 0; d < 2; ++d) { oacc[d] = MFMA32(vfa[d][0], pf0, oacc[d]); oacc[d] = MFMA32(vfa[d][1], pf1, oacc[d]); }
#pragma unroll
                for (int d = 0; d < 2; ++d) { vfb[d][0] = ld_perm(Vs + (32 * (d + 2) + r) * VLD + 32 * kb + 4 * h2); vfb[d][1] = ld_perm(Vs + (32 * (d + 2) + r) * VLD + 32 * kb + 16 + 4 * h2); }
                if (kb == 1 && j + 1 < ntiles && amode != 5) ATT_ISSUE_V(j + 1);
                __builtin_amdgcn_sched_barrier(0);
#pragma unroll
                for (int d = 0; d < 2; ++d) { oacc[d + 2] = MFMA32(vfb[d][0], pf0, oacc[d + 2]); oacc[d + 2] = MFMA32(vfb[d][1], pf1, oacc[d + 2]); }
            }
        } else if (j + 1 < ntiles && amode != 5) ATT_ISSUE_V(j + 1);
    }
#undef ATT_ISSUE
#undef ATT_ISSUE_K
#undef ATT_ISSUE_V
    l_run += __shfl_xor(l_run, 32);
    if (rep && l_run != 12345.678f) return;
    const float inv = __builtin_amdgcn_rcpf(l_run);
    bf16_t* op = O + (size_t)(q0 + r) * ldo;
#pragma unroll
    for (int d = 0; d < 4; ++d)
#pragma unroll
        for (int i4 = 0; i4 < 4; ++i4) { u32x2 o; o[0] = pk2(oacc[d][4 * i4] * inv, oacc[d][4 * i4 + 1] * inv); o[1] = pk2(oacc[d][4 * i4 + 2] * inv, oacc[d][4 * i4 + 3] * inv);
            *(u32x2*)(op + 32 * d + 8 * i4 + 4 * h2) = o; }
}

DI void sg_item(int item, const bf16_t* proj, const bf16_t* sgw, const float* vng, const float* bs, bf16_t* obuf, unsigned char* smem, const int tid) {
    const int lane = tid & 63, wv = tid >> 6, r = lane & 31, h2 = lane >> 5;
    const int g = item & 3, n = (item >> 2) & 31, b = item >> 7;
    const int t0 = b * SEQ + n * 128;
    bf16_t* vT = (bf16_t*)smem;
    const int tb = wv >> 1;
    const bf16_t* W = sgw + (size_t)g * 16384;
    bf16x8 wf[8];
#pragma unroll
    for (int ks = 0; ks < 8; ++ks) wf[ks] = *(const bf16x8*)(W + (32 * tb + r) * 128 + 16 * ks + 8 * h2);
    float va[16][2];
#pragma unroll
    for (int e = 0; e < 16; ++e) { const bf16_t* vr = proj + (size_t)(t0 + wv * 16 + e) * PLD + 3008 + g * 128; va[e][0] = bf2f(vr[lane]); va[e][1] = bf2f(vr[lane + 64]); }
    const float g0 = vng[g * 128 + lane], g1 = vng[g * 128 + lane + 64];
    __syncthreads();
#pragma unroll
    for (int e = 0; e < 16; ++e) { const int tt = wv * 16 + e;
        const float a0 = geluf_(va[e][0]), a1 = geluf_(va[e][1]);
        const float ss = wave_sum(a0 * a0 + a1 * a1); const float rs = rsqrtf(ss * (1.f / 128.f) + NEPS);
        vT[lane * 136 + tt] = f2bf(a0 * rs * g0); vT[(lane + 64) * 136 + tt] = f2bf(a1 * rs * g1); }
    __syncthreads();
#pragma unroll
    for (int ci = 0; ci < 2; ++ci) { const int cb = 2 * (wv & 1) + ci; const int c = 32 * cb + r;
        float uv[16];
#pragma unroll
        for (int i = 0; i < 16; ++i) uv[i] = bf2f(proj[(size_t)(t0 + 32 * tb + crow(i, h2)) * PLD + 2496 + g * 128 + c]);
        f32x16 acc; for (int i = 0; i < 16; ++i) acc[i] = 0.f;
#pragma unroll
        for (int ks = 0; ks < 8; ++ks) if (ks < 2 * (tb + 1)) acc = MFMA32(wf[ks], *(const bf16x8*)(vT + (32 * cb + r) * 136 + 16 * ks + 8 * h2), acc);
#pragma unroll
        for (int i = 0; i < 16; ++i) { const int t = 32 * tb + crow(i, h2);
            obuf[(size_t)(t0 + t) * 2048 + 1024 + g * 128 + c] = f2bf(geluf_(uv[i]) * (acc[i] + bs[g * 128 + t])); } }
}

#define XB_TMO      128
#define XB_XCNT(j)  (256  + 64 * (j))
#define XB_XSUB(j)  (1280 + 64 * (j))
#define XB_XGEN(j)  (2304 + 64 * (j))
#define XB_TOP      3328
#define XB_TOPGEN   3392
#define XCD_BAR_WORDS 3456
#define XB_SPIN_CAP (1u << 18)

__device__ __forceinline__ unsigned xb_ld(unsigned* p)              { return __hip_atomic_load(p, __ATOMIC_RELAXED, __HIP_MEMORY_SCOPE_AGENT); }
__device__ __forceinline__ unsigned xb_add(unsigned* p, unsigned v) { return __hip_atomic_fetch_add(p, v, __ATOMIC_RELAXED, __HIP_MEMORY_SCOPE_AGENT); }
__device__ __forceinline__ unsigned xb_xcc_id() { return (unsigned)__builtin_amdgcn_s_getreg((3 << 11) | 20) & 0xFu; }
#define XB_SPIN(cond, bar) do { unsigned _sp = 0; while (cond) { __builtin_amdgcn_s_sleep(1); \
    if ((++_sp & 255u) == 0u) { if (xb_ld(&(bar)[XB_TMO])) break; if (_sp > XB_SPIN_CAP) { atomicAdd(&(bar)[XB_TMO], 1u); break; } } } } while (0)

struct XcdBarrier {
    unsigned* bar; unsigned x;
    volatile LAS unsigned* st;
};

__device__ __forceinline__ XcdBarrier xcd_barrier_post(unsigned* bar, volatile LAS unsigned* st) {
    XcdBarrier b; b.bar = bar; b.x = xb_xcc_id(); b.st = st;
    if (threadIdx.x == 0) (void)xb_add(&bar[XB_XCNT(b.x)], 1u);
    return b;
}
__device__ __forceinline__ void xcd_barrier_complete(unsigned* bar, unsigned x, unsigned& nloc, unsigned& nx) {
    const unsigned G = gridDim.x * gridDim.y * gridDim.z;
    unsigned sum, cnt, mine, sp = 0u;
    for (;;) {
        sum = 0u; cnt = 0u; mine = 0u;
#pragma unroll
        for (unsigned j = 0; j < 16; ++j) { const unsigned c = xb_ld(&bar[XB_XCNT(j)]); sum += c; cnt += (c > 0u) ? 1u : 0u; mine = (j == x) ? c : mine; }
        if (sum == G) break;
        __builtin_amdgcn_s_sleep(1);
        if ((++sp & 255u) == 0u) { if (xb_ld(&bar[XB_TMO])) break; if (sp > XB_SPIN_CAP) { atomicAdd(&bar[XB_TMO], 1u); break; } }
    }
    nloc = mine > 0u ? mine : 1u; nx = cnt > 0u ? cnt : 1u;
}

__device__ __forceinline__ void xcd_barrier(const XcdBarrier& b) {
    asm volatile("s_waitcnt vmcnt(0)" ::: "memory");
    __syncthreads();
    if (threadIdx.x == 0) {
        unsigned* bar = b.bar;
        __builtin_amdgcn_s_waitcnt(0);
        unsigned nloc = b.st[0], nx = b.st[1];
        if (nloc == 0u) { xcd_barrier_complete(bar, b.x, nloc, nx); b.st[0] = nloc; b.st[1] = nx; }
        const unsigned old = xb_add(&bar[XB_XSUB(b.x)], 1u);
        const unsigned gen = old / nloc;
        if (old + 1u == (gen + 1u) * nloc) {
            __builtin_amdgcn_fence(__ATOMIC_RELEASE, "agent");
            asm volatile("s_waitcnt vmcnt(0)" ::: "memory");
            const unsigned og = xb_add(&bar[XB_TOP], 1u);
            const unsigned tg = og / nx;
            if (og + 1u == (tg + 1u) * nx) xb_add(&bar[XB_TOPGEN], 1u);
            else XB_SPIN(xb_ld(&bar[XB_TOPGEN]) == tg, bar);
            __builtin_amdgcn_fence(__ATOMIC_ACQUIRE, "agent");
            xb_add(&bar[XB_XGEN(b.x)], 1u);
            asm volatile("s_waitcnt vmcnt(0)" ::: "memory");
        } else {
            XB_SPIN(xb_ld(&bar[XB_XGEN(b.x)]) == gen, bar);
            __builtin_amdgcn_fence(__ATOMIC_ACQUIRE, "agent");
            asm volatile("s_waitcnt vmcnt(0)" ::: "memory");
        }
    }
    __syncthreads();
}

#define PIN(k) (p.in[k])
#define POUT (p.out)
DI void run_phase(const Params& p, int ph, unsigned char* smem, const int tid, const int rep) {
    const int l = ph / N_STEPS, s = ph % N_STEPS;
    const int lane = tid & 63, wv = tid >> 6;
    unsigned char* ws = p.ws;
    bf16_t* wt_in = (bf16_t*)(ws + OFF_WT_IN); bf16_t* wt_gate = (bf16_t*)(ws + OFF_WT_GATE); bf16_t* wt_mla = (bf16_t*)(ws + OFF_WT_MLA); bf16_t* wt_br = (bf16_t*)(ws + OFF_WT_BR);
    bf16_t* wt_out = (bf16_t*)(ws + OFF_WT_OUT); bf16_t* wt_ff1 = (bf16_t*)(ws + OFF_WT_FF1); bf16_t* wt_ff2 = (bf16_t*)(ws + OFF_WT_FF2); bf16_t* sgw = (bf16_t*)(ws + OFF_SGW);
    bf16_t* hbuf = (bf16_t*)(ws + OFF_HBUF); bf16_t* proj = (bf16_t*)(ws + OFF_PROJ); float* small = (float*)(ws + OFF_SMALL);
    bf16_t* mlaa = (bf16_t*)(ws + OFF_MLAA); bf16_t* mlaraw = (bf16_t*)(ws + OFF_MLARAW); bf16_t* mlaq = (bf16_t*)(ws + OFF_MLAQ); bf16_t* mlak = (bf16_t*)(ws + OFF_MLAK);
    bf16_t* mlavt = (bf16_t*)(ws + OFF_MLAVT); bf16_t* foxvt = (bf16_t*)(ws + OFF_FOXVT); float* foxcum = (float*)(ws + OFF_FOXCUM);
    bf16_t* obuf = (bf16_t*)(ws + OFF_OBUF); bf16_t* Pb = (bf16_t*)(ws + OFF_P); bf16_t* merged = (bf16_t*)(ws + OFF_MERGED); bf16_t* hid = (bf16_t*)(ws + OFF_HID);
    unsigned* ctr = (unsigned*)ws;
    LAS unsigned char* lds = (LAS unsigned char*)smem;
    const float* xsrc = (l == 0) ? PIN(0) : POUT;

    if (s == 0) {
        float* tl = (float*)smem;
        { const float* w = PIN(3) + (size_t)l * 1024 * 9164;
          convert_mat(wt_in, 5120, 1024, [&](int n, int k) -> float { int sc; if (n < 2048) sc = n; else if (n < 5056) sc = n + 8; else if (n < 5064) sc = n - 5056 + 2048; else if (n < 5068) sc = n; else sc = -1;
              const float vv = w[(size_t)k * 9164 + (sc >= 0 ? sc : 0)]; return sc >= 0 ? vv : 0.f; }, tl, tid);
          convert_mat(wt_gate, 4096, 1024, [&](int n, int k) -> float { const int pn = n >> 8, c = n & 255, bj = c >> 7, wc = (c >> 5) & 3, nn = (c >> 4) & 1, fq = (c >> 2) & 3, j = c & 3;
              const int d = 64 * pn + 16 * wc + 4 * fq + 2 * bj + nn; return w[(size_t)k * 9164 + 5068 + j * 1024 + d]; }, tl, tid); }
        { const float* wq = PIN(10) + (size_t)l * 256 * 768; const float* wkv = PIN(11) + (size_t)l * 128 * 1024;
          convert_mat(wt_mla, 1792, 256, [&](int n, int k) -> float { const bool isq = n < 768; const bool ok = isq || (k >= 128); const float* bp = isq ? wq : wkv; const size_t off = ok ? (isq ? (size_t)k * 768 + n : (size_t)(k - 128) * 1024 + (n - 768)) : 0; const float vv = bp[off]; return ok ? vv : 0.f; }, tl, tid); }
        { const float* w = PIN(20) + (size_t)l * 4 * 512 * 1024; convert_mat(wt_br, 4096, 512, [&](int n, int k) -> float { return w[((size_t)(n >> 10) * 512 + k) * 1024 + (n & 1023)]; }, tl, tid); }
        { const float* w = PIN(21) + (size_t)l * 1024 * 1024; convert_mat(wt_out, 1024, 1024, [&](int n, int k) -> float { return w[(size_t)k * 1024 + n]; }, tl, tid); }
        { const float* w = PIN(23) + (size_t)l * 1024 * 4096; convert_mat(wt_ff1, 4096, 1024, [&](int n, int k) -> float { return w[(size_t)k * 4096 + n]; }, tl, tid); }
        { const float* w = PIN(24) + (size_t)l * 4096 * 1024; convert_mat(wt_ff2, 1024, 4096, [&](int n, int k) -> float { return w[(size_t)k * 1024 + n]; }, tl, tid); }
        { const float* w = PIN(15) + (size_t)l * 4 * 128 * 128;
          for (int i = blockIdx.x * NTHR + tid; i < 4 * 128 * 128; i += gridDim.x * NTHR) { const int t = (i >> 7) & 127, sx = i & 127; const float vv = w[i]; sgw[i] = f2bf(sx <= t ? vv : 0.f); } }
        rmsnorm_phase(xsrc, PIN(2) + l * 1024, hbuf, 65536, tid);
        return;
    }
    if (s == 17) { rmsnorm_phase(POUT, PIN(22) + l * 1024, hbuf, 65536, tid); return; }
    if (s == 18) { pg8::Gemm g{hbuf, wt_ff1, 1024, 1024, 1024, 256, 16, 1, 0, 0, 1 << 30, 0}; pg8::EpiBf16<1> E{hid, 4096, 0}; pg8::gemm_phase(lds, g, E, tid); return; }
    if (s == 19) { pg8::Gemm g{hid, wt_ff2, 4096, 4096, 4096, 256, 4, 1, 0, 0, 1 << 30, 0}; pg8::EpiResid E{POUT, POUT}; pg8::gemm_phase(lds, g, E, tid); return; }

    const int hb = (s - 1) / 8, st = (s - 1) % 8 + 1;
    const size_t tok0 = (size_t)hb * TS;
    switch (st) {
    case 1: { pg8::Gemm g{hbuf + tok0 * 1024, wt_in, 1024, 1024, 1024, 128, 20, 1, 0, 0, 1 << 30, 0}; pg8::EpiProj E{proj, small}; pg8::gemm_phase(lds, g, E, tid); } break;
    case 2: {
        if (rep == 0) { const float* gq = PIN(8) + l * 256; const float* gkv = PIN(9) + l * 128; const float* fqg = PIN(17) + l * 128; const float* fkg = PIN(18) + l * 128;
          const f32x4 ggq = *(const f32x4*)(gq + 4 * lane); const float gkv0 = gkv[2 * lane], gkv1 = gkv[2 * lane + 1];
          const float fq0 = fqg[2 * lane], fq1 = fqg[2 * lane + 1], fk0 = fkg[2 * lane], fk1 = fkg[2 * lane + 1];
          for (int t0 = (blockIdx.x * 8 + wv) * 4; t0 < TS; t0 += gridDim.x * 32) {
              u32x2 vq[4]; unsigned vkv[4], vf[4][8];
#pragma unroll
              for (int u = 0; u < 4; ++u) { const bf16_t* pr = proj + (size_t)(t0 + u) * PLD; vq[u] = *(const u32x2*)(pr + 2048 + 4 * lane); vkv[u] = *(const unsigned*)(pr + 2304 + 2 * lane);
#pragma unroll
                  for (int hq = 0; hq < 8; ++hq) vf[u][hq] = *(const unsigned*)(pr + 3520 + hq * 128 + 2 * lane); }
#pragma unroll
              for (int u = 0; u < 4; ++u) { const int t = t0 + u; bf16_t* pr = proj + (size_t)t * PLD;
                  { const u32x2 v = vq[u]; const float a0 = __uint_as_float(v[0] << 16), a1 = __uint_as_float(v[0] & 0xffff0000u), a2 = __uint_as_float(v[1] << 16), a3 = __uint_as_float(v[1] & 0xffff0000u);
                    const float rs = rsqrtf(wave_sum(a0 * a0 + a1 * a1 + a2 * a2 + a3 * a3) * (1.f / 256.f) + NEPS);
                    u32x2 o; o[0] = pk2(a0 * rs * ggq[0], a1 * rs * ggq[1]); o[1] = pk2(a2 * rs * ggq[2], a3 * rs * ggq[3]); *(u32x2*)(mlaa + (size_t)t * 384 + 4 * lane) = o; }
                  { const unsigned v = vkv[u]; const float a0 = __uint_as_float(v << 16), a1 = __uint_as_float(v & 0xffff0000u);
                    const float rs = rsqrtf(wave_sum(a0 * a0 + a1 * a1) * (1.f / 128.f) + NEPS);
                    *(unsigned*)(mlaa + (size_t)t * 384 + 256 + 2 * lane) = pk2(a0 * rs * gkv0, a1 * rs * gkv1); }
#pragma unroll
                  for (int hq = 0; hq < 8; ++hq) { const unsigned v = vf[u][hq]; const float a0 = __uint_as_float(v << 16), a1 = __uint_as_float(v & 0xffff0000u);
                    const float rs = rsqrtf(wave_sum(a0 * a0 + a1 * a1) * (1.f / 128.f) + NEPS) * ((hq < 4) ? 0.08838834764831845f * LOG2E : 1.f);
                    *(unsigned*)(pr + 3520 + hq * 128 + 2 * lane) = pk2(a0 * rs * ((hq < 4) ? fq0 : fk0), a1 * rs * ((hq < 4) ? fq1 : fk1)); } } } }
        if (blockIdx.x < 32 && (rep == 0 || PROBE_SUB == 1)) { const int b = blockIdx.x >> 2, h = blockIdx.x & 3; const float fb = PIN(19)[l * 4 + h]; float* red = (float*)smem;
            float lf[8]; float tot = 0.f;
#pragma unroll
            for (int e = 0; e < 8; ++e) { const float x = small[(size_t)(b * SEQ + tid * 8 + e) * 16 + 8 + h] + fb; lf[e] = fminf(x, 0.f) - log1pf(__expf(-fabsf(x))); tot += lf[e]; }
            float inc = tot; for (int o = 1; o < 64; o <<= 1) { const float t = __shfl_up(inc, o); if (lane >= o) inc += t; }
            __syncthreads();
            if (lane == 63) red[wv] = inc;
            __syncthreads();
            float base = inc - tot; for (int w = 0; w < wv; ++w) base += red[w];
            f32x4 o0, o1; float run = base;
#pragma unroll
            for (int e = 0; e < 4; ++e) { run += lf[e]; o0[e] = run; }
#pragma unroll
            for (int e = 0; e < 4; ++e) { run += lf[4 + e]; o1[e] = run; }
            float* dp = foxcum + (size_t)(b * 4 + h) * SEQ + tid * 8; *(f32x4*)dp = o0; *(f32x4*)(dp + 4) = o1;
            __syncthreads(); }
        if (rep == 0 || PROBE_SUB == 2) transpose_v_phase(proj, PLD, 3520 + 1024, 128, foxvt, (bf16_t*)smem, tid);
        { DnPrepArgs a{proj, small, PIN(4) + (size_t)l * 4 * 1536, PIN(5) + l * 4, PIN(6) + l * 4,
                       (bf16_t*)(ws + OFF_DN_QDEC), (bf16_t*)(ws + OFF_DN_NEGW), (bf16_t*)(ws + OFF_DN_U), (bf16_t*)(ws + OFF_DN_KDT), (bf16_t*)(ws + OFF_DN_AQK), (float*)(ws + OFF_DN_GLAST)};
          if (rep == 0 || PROBE_SUB == 3) for (int it = blockIdx.x; it < NCH; it += gridDim.x) { int tq = tid; asm volatile("" : "+v"(tq)); dn_prep_item(it, a, smem, tq, rep ? PROBE_LIM : 9); } }
    } break;
    case 3: { pg8::Gemm g{mlaa, wt_mla, 384, 256, 256, 128, 7, 1, 0, 0, 3, 128}; pg8::EpiBf16<0> E{mlaraw, 1792, 0}; pg8::gemm_phase(lds, g, E, tid); } break;
    case 4: {
        const float* gqq = PIN(12) + l * 192; const float* gkk = PIN(13) + l * 192; const int* pos = (const int*)PIN(1);
        const int fi = lane & 31; const float invf = powf(10000.f, -(float)(2 * fi) / 64.f);
        const float gq0 = gqq[lane], gq1 = gqq[lane + 64], gq2 = gqq[lane + 128], gk0 = gkk[lane], gk1 = gkk[lane + 64], gk2 = gkk[lane + 128];
        for (int t0 = (blockIdx.x * 8 + wv) * 2; t0 < TS; t0 += gridDim.x * 16) {
            float krv[2], qa[2][4][3], ka[2][4][2]; int ps[2];
#pragma unroll
            for (int u = 0; u < 2; ++u) { const int t = t0 + u; ps[u] = pos[tok0 + t]; krv[u] = bf2f(proj[(size_t)t * PLD + 2432 + lane]);
#pragma unroll
                for (int h = 0; h < 4; ++h) { const bf16_t* qr = mlaraw + (size_t)t * 1792 + h * 192; const bf16_t* kp = mlaraw + (size_t)t * 1792 + 768 + h * 256;
                    qa[u][h][0] = bf2f(qr[lane]); qa[u][h][1] = bf2f(qr[lane + 64]); qa[u][h][2] = bf2f(qr[lane + 128]); ka[u][h][0] = bf2f(kp[lane]); ka[u][h][1] = bf2f(kp[lane + 64]); } }
#pragma unroll
            for (int u = 0; u < 2; ++u) { const int t = t0 + u;
                const float ang = (float)ps[u] * invf; float sn, cs; sincosf(ang, &sn, &cs);
                const float kr = krv[u];
#pragma unroll
                for (int h = 0; h < 4; ++h) {
                    { const float a0 = qa[u][h][0], a1 = qa[u][h][1], a2 = qa[u][h][2];
                      const float rs = rsqrtf(wave_sum(a0 * a0 + a1 * a1 + a2 * a2) * (1.f / 192.f) + NEPS) * (0.07216878364870322f * LOG2E);
                      const float y2 = a2 * rs * gq2; const float oth = __shfl_xor(y2, 32);
                      const float rot = (lane < 32) ? (y2 * cs - oth * sn) : (y2 * cs + oth * sn);
                      bf16_t* qo = mlaq + (size_t)t * 768 + h * 192; qo[lane] = f2bf(a0 * rs * gq0); qo[lane + 64] = f2bf(a1 * rs * gq1); qo[lane + 128] = f2bf(rot); }
                    { const float a0 = ka[u][h][0], a1 = ka[u][h][1];
                      const float rs = rsqrtf(wave_sum(a0 * a0 + a1 * a1 + kr * kr) * (1.f / 192.f) + NEPS);
                      const float y2 = kr * rs * gk2; const float oth = __shfl_xor(y2, 32);
                      const float rot = (lane < 32) ? (y2 * cs - oth * sn) : (y2 * cs + oth * sn);
                      bf16_t* ko = mlak + (size_t)t * 768 + h * 192; ko[lane] = f2bf(a0 * rs * gk0); ko[lane + 64] = f2bf(a1 * rs * gk1); ko[lane + 128] = f2bf(rot); }
                }
            }
        }
        transpose_v_phase(mlaraw, 1792, 768 + 128, 256, mlavt, (bf16_t*)smem, tid);
    } break;
    case 5: {
        DnScanArgs da{(bf16_t*)(ws + OFF_DN_QDEC), (bf16_t*)(ws + OFF_DN_NEGW), (bf16_t*)(ws + OFF_DN_U), (bf16_t*)(ws + OFF_DN_KDT), (bf16_t*)(ws + OFF_DN_AQK), (float*)(ws + OFF_DN_GLAST), obuf, proj, PIN(7) + l * 128};
        int* s_item = (int*)(smem + LDS_BYTES - 64);
        { const float* g1 = PIN(12) + l * 192; const float* g2 = PIN(13) + l * 192; const float* g3 = PIN(17) + l * 128; const float* g4 = PIN(18) + l * 128;
          float a1 = fmaxf(fmaxf(fabsf(g1[lane]), fabsf(g1[lane + 64])), fabsf(g1[lane + 128])), a2 = fmaxf(fmaxf(fabsf(g2[lane]), fabsf(g2[lane + 64])), fabsf(g2[lane + 128]));
          float a3 = fmaxf(fabsf(g3[lane]), fabsf(g3[lane + 64])), a4 = fmaxf(fabsf(g4[lane]), fabsf(g4[lane + 64]));
          for (int o = 32; o; o >>= 1) { a1 = fmaxf(a1, __shfl_xor(a1, o)); a2 = fmaxf(a2, __shfl_xor(a2, o)); a3 = fmaxf(a3, __shfl_xor(a3, o)); a4 = fmaxf(a4, __shfl_xor(a4, o)); }
          if (tid == 0) { float* mp = (float*)(smem + LDS_BYTES - 48); mp[0] = a1 * a2 * 13.856406460551018f * LOG2E; mp[1] = a3 * a4 * 11.313708498984761f * LOG2E; } }
        if (tid == 0) s_item[1] = 0;
        for (;;) {
            __syncthreads();
            if (tid == 0) { int qi = s_item[1]; const int xcc = (int)(xb_xcc_id() & 7u); int v = -1;
                for (; qi < 8; ++qi) { const int xq = (xcc + qi) & 7; const int li = (int)atomicAdd(ctr + 128 + ph * 8 + xq, 1u); if (li < 4 + 128 + 128) { v = (xq << 16) | li; break; } }
                s_item[1] = qi; s_item[0] = v; }
            __syncthreads();
            const int v = *s_item;
            if (v < 0) break;
            const int xq = v >> 16, li = v & 0xffff;
            int tq = tid; asm volatile("" : "+v"(tq));
            if (li < 4) dn_scan_item(xq * 4 + li, da, smem, tq);
            else if (li < 4 + 128) { const int idx = li - 4, qt = 15 - (idx >> 3), rr = xq * 8 + (idx & 7), type = rr & 1, bh = rr >> 1, b = bh >> 2, h = bh & 3;
                if (type == 0) attn_item<192, false>(mlaq + (size_t)b * SEQ * 768 + h * 192, 768, mlak + (size_t)b * SEQ * 768 + h * 192, 768, mlavt + (size_t)bh * 128 * SEQ, nullptr,
                                                     obuf + (size_t)b * SEQ * 2048 + 512 + h * 128, 2048, qt, ((const float*)(smem + LDS_BYTES - 48))[0], smem, tq, rep);
                else attn_item<128, true>(proj + (size_t)b * SEQ * PLD + 3520 + h * 128, PLD, proj + (size_t)b * SEQ * PLD + 3520 + 512 + h * 128, PLD, foxvt + (size_t)bh * 128 * SEQ, foxcum + (size_t)bh * SEQ,
                                          obuf + (size_t)b * SEQ * 2048 + 1536 + h * 128, 2048, qt, ((const float*)(smem + LDS_BYTES - 48))[1], smem, tq, rep); }
            else sg_item(xq * 128 + (li - 132), proj, sgw, PIN(14) + l * 512, PIN(16) + l * 512, obuf, smem, tq);
        }
    } break;
    case 6: { pg8::Gemm g{obuf, wt_br, 2048, 512, 512, 128, 4, 4, 512, (long)1024 * 512, 1 << 30, 0}; pg8::EpiBf16<0> E{Pb, 4096, 1024}; pg8::gemm_phase(lds, g, E, tid); } break;
    case 7: { pg8::Gemm g{hbuf + tok0 * 1024, wt_gate, 1024, 1024, 1024, 128, 16, 1, 0, 0, 1 << 30, 0}; pg8::EpiMerge E{Pb, merged}; pg8::gemm_phase(lds, g, E, tid); } break;
    case 8: { pg8::Gemm g{merged, wt_out, 1024, 1024, 1024, 128, 4, 1, 0, 0, 1 << 30, 0}; pg8::EpiResid E{POUT + tok0 * 1024, xsrc + tok0 * 1024}; pg8::gemm_phase(lds, g, E, tid); } break;
    }
}

__global__ void __launch_bounds__(512, 2) mega(Params p) {
    extern __shared__ __attribute__((aligned(16))) unsigned char smem[];
    cg::grid_group grid = cg::this_grid();
    volatile LAS unsigned* bst = (volatile LAS unsigned*)(LAS unsigned char*)(smem + LDS_BYTES - 32);
    if (threadIdx.x == 0) { bst[0] = 0u; bst[1] = 0u; }
    __syncthreads();
    XcdBarrier xb; xb.bar = (unsigned*)(p.ws + 4096); xb.x = 0; xb.st = bst;
    const bool multi = (p.ph_hi - p.ph_lo) > 1;
    if (multi) xb = xcd_barrier_post((unsigned*)(p.ws + 4096), bst);
    for (int ph = p.ph_lo; ph < p.ph_hi; ++ph) {
        if (ph == p.ph_lo + 1) grid.sync();
        else if (ph > p.ph_lo) xcd_barrier(xb);
#if PROBE_SYNCS
        for (int e = 0; e < PROBE_SYNCS; ++e) xcd_barrier(xb);
#endif
        int tid = threadIdx.x; asm volatile("" : "+v"(tid));
        run_phase(p, ph, smem, tid, 0);
#if PROBE_ST == 2
        { const int s_ = ph % N_STEPS; const int st_ = (s_ >= 1 && s_ <= 16) ? (s_ - 1) % 8 + 1 : (s_ == 0 ? 0 : s_);
          if (st_ == 2) { xcd_barrier(xb); const int l_ = ph / N_STEPS; unsigned char* ws = p.ws;
              DnPrepArgs a{(bf16_t*)(ws + OFF_PROJ), (float*)(ws + OFF_SMALL), p.in[4] + (size_t)l_ * 4 * 1536, p.in[5] + l_ * 4, p.in[6] + l_ * 4,
                           (bf16_t*)(ws + OFF_DN_QDEC), (bf16_t*)(ws + OFF_DN_NEGW), (bf16_t*)(ws + OFF_DN_U), (bf16_t*)(ws + OFF_DN_KDT), (bf16_t*)(ws + OFF_DN_AQK), (float*)(ws + OFF_DN_GLAST)};
              for (int it = blockIdx.x; it < NCH; it += gridDim.x) { int tq = threadIdx.x; asm volatile("" : "+v"(tq)); dn_prep_item(it, a, smem, tq, PROBE_LIM); } } }
#elif PROBE_ST >= 0
        { const int s_ = ph % N_STEPS; const int st_ = (s_ >= 1 && s_ <= 16) ? (s_ - 1) % 8 + 1 : (s_ == 0 ? 0 : s_);
          if (st_ == PROBE_ST) { xcd_barrier(xb); int t2 = threadIdx.x; asm volatile("" : "+v"(t2)); run_phase(p, ph, smem, t2, 1); } }
#endif
    }
}

#ifndef N_LAUNCH_MODE
#define N_LAUNCH_MODE 1
#endif

extern "C" void kernel_launch(void* const* d_in, const int* in_sizes, int n_in, void* d_out, int out_size, void* d_ws, size_t ws_size, hipStream_t stream) {
    static int grid = 0;
    if (grid == 0) {
        if (n_in != 25 || ws_size < OFF_END) { fprintf(stderr, "kernel_launch: unexpected n_in %d or workspace %zu < %zu\n", n_in, ws_size, (size_t)OFF_END); grid = -1; return; }
        int dev = 0, cus = 0, per_cu = 0;
        hipGetDevice(&dev); hipDeviceGetAttribute(&cus, hipDeviceAttributeMultiprocessorCount, dev);
        if (hipFuncSetAttribute((const void*)mega, hipFuncAttributeMaxDynamicSharedMemorySize, LDS_BYTES) != hipSuccess) { fprintf(stderr, "kernel_launch: hipFuncSetAttribute failed\n"); grid = -1; return; }
        if (hipOccupancyMaxActiveBlocksPerMultiprocessor(&per_cu, (const void*)mega, NTHR, LDS_BYTES) != hipSuccess || per_cu < 1) { fprintf(stderr, "kernel_launch: occupancy query gave %d\n", per_cu); per_cu = 1; }
        (void)hipGetLastError();
        grid = cus * per_cu;
    }
    if (grid < 0) return;
    hipMemsetAsync(d_ws, 0, SZ_CTL, stream);
    Params p{};
    for (int i = 0; i < 25; ++i) p.in[i] = (const float*)d_in[i];
    p.out = (float*)d_out; p.ws = (unsigned char*)d_ws;
#if N_LAUNCH_MODE == 1
    p.ph_lo = 0; p.ph_hi = N_PHASES;
    void* args[] = {&p};
    hipError_t e = hipLaunchCooperativeKernel((const void*)mega, dim3(grid), dim3(NTHR), args, LDS_BYTES, stream);
    if (e != hipSuccess) fprintf(stderr, "cooperative launch failed: %s (grid %d)\n", hipGetErrorString(e), grid);
#else
    for (int ph = 0; ph < N_PHASES; ++ph) { p.ph_lo = ph; p.ph_hi = ph + 1; hipLaunchKernelGGL(mega, dim3(grid), dim3(NTHR), LDS_BYTES, stream, p); }
#endif
}
```

```cpp
#include <hip/hip_runtime.h>
#include <hip/hip_cooperative_groups.h>
#include <cstdio>
namespace cg = cooperative_groups;

#define DI __device__ __forceinline__
#define LAS __attribute__((address_space(3)))
typedef unsigned short bf16_t;
typedef short bf16x8 __attribute__((ext_vector_type(8)));
typedef short s16x4 __attribute__((ext_vector_type(4)));
typedef float f32x4 __attribute__((ext_vector_type(4)));
typedef float f32x16 __attribute__((ext_vector_type(16)));
typedef unsigned u32x4 __attribute__((ext_vector_type(4)));
typedef unsigned u32x2 __attribute__((ext_vector_type(2)));

#define PROBE_ST -1
#define PROBE_SYNCS 0
#define PROBE_SUB 0
#define PROBE_LIM 9
constexpr int TS = 32768, SEQ = 4096, PLD = 5056, NTHR = 512;
constexpr int LDS_BYTES = 160 * 1024;
constexpr int N_STEPS = 20, N_PHASES = 4 * N_STEPS;
constexpr float NEPS = 1e-6f;
constexpr float LOG2E = 1.4426950408889634f;

constexpr size_t SZ_CTL = 32768;
constexpr size_t OFF_WT_IN = SZ_CTL;
constexpr size_t OFF_WT_GATE = OFF_WT_IN + (size_t)5120 * 1024 * 2;
constexpr size_t OFF_WT_MLA = OFF_WT_GATE + (size_t)4096 * 1024 * 2;
constexpr size_t OFF_WT_BR = OFF_WT_MLA + (size_t)1792 * 384 * 2;
constexpr size_t OFF_WT_OUT = OFF_WT_BR + (size_t)4096 * 512 * 2;
constexpr size_t OFF_WT_FF1 = OFF_WT_OUT + (size_t)1024 * 1024 * 2;
constexpr size_t OFF_WT_FF2 = OFF_WT_FF1 + (size_t)4096 * 1024 * 2;
constexpr size_t OFF_SGW = OFF_WT_FF2 + (size_t)1024 * 4096 * 2;
constexpr size_t OFF_HBUF = OFF_SGW + (size_t)4 * 128 * 128 * 2;
constexpr size_t OFF_HB = OFF_HBUF + (size_t)65536 * 1024 * 2;
constexpr size_t OFF_PROJ = OFF_HB;
constexpr size_t OFF_SMALL = OFF_PROJ + (size_t)TS * PLD * 2;
constexpr size_t OFF_MLAA = OFF_SMALL + (size_t)TS * 16 * 4;
constexpr size_t OFF_MLARAW = OFF_MLAA + (size_t)TS * 384 * 2;
constexpr size_t OFF_MLAQ = OFF_MLARAW + (size_t)TS * 1792 * 2;
constexpr size_t OFF_MLAK = OFF_MLAQ + (size_t)TS * 768 * 2;
constexpr size_t OFF_MLAVT = OFF_MLAK + (size_t)TS * 768 * 2;
constexpr size_t OFF_FOXVT = OFF_MLAVT + (size_t)TS * 512 * 2;
constexpr size_t OFF_FOXCUM = OFF_FOXVT + (size_t)TS * 512 * 2;
constexpr size_t OFF_DNP = OFF_FOXCUM + (size_t)TS * 4 * 4;
constexpr int NCH = 2048;
constexpr size_t DNP_MAT = (size_t)NCH * 8192 * 2;
constexpr size_t OFF_DN_QDEC = OFF_DNP, OFF_DN_NEGW = OFF_DNP + DNP_MAT, OFF_DN_U = OFF_DNP + 2 * DNP_MAT, OFF_DN_KDT = OFF_DNP + 3 * DNP_MAT;
constexpr size_t OFF_DN_AQK = OFF_DNP + 4 * DNP_MAT;
constexpr size_t OFF_DN_GLAST = OFF_DN_AQK + (size_t)NCH * 4096 * 2;
constexpr size_t OFF_END = OFF_DN_GLAST + (size_t)NCH * 4;
constexpr size_t OFF_OBUF = OFF_MLAA;
constexpr size_t OFF_P = OFF_PROJ;
constexpr size_t OFF_MERGED = OFF_DNP;
constexpr size_t OFF_HID = OFF_HB;
static_assert((size_t)TS * 2048 * 2 <= OFF_MLAQ - OFF_MLAA, "obuf overlay");
static_assert((size_t)65536 * 4096 * 2 <= OFF_END - OFF_HB, "hid overlay");

struct Params { const float* in[25]; float* out; unsigned char* ws; int ph_lo, ph_hi; };

DI float bf2f(bf16_t b) { return __uint_as_float(((unsigned)b) << 16); }
DI bf16_t f2bf(float f) { unsigned u = __float_as_uint(f); u += 0x7fffu + ((u >> 16) & 1u); return (bf16_t)(u >> 16); }
typedef __bf16 bf16v2_t __attribute__((ext_vector_type(2)));
typedef float f32x2 __attribute__((ext_vector_type(2)));
DI unsigned pk2(float lo, float hi) { const f32x2 v = {lo, hi}; return __builtin_bit_cast(unsigned, __builtin_convertvector(v, bf16v2_t)); }
DI float wave_sum(float v) { for (int o = 32; o; o >>= 1) v += __shfl_xor(v, o); return v; }
DI float sigmoidf_(float x) { return __builtin_amdgcn_rcpf(1.f + __builtin_amdgcn_exp2f(-LOG2E * x)); }
DI float sigp_(float y) { return __builtin_amdgcn_rcpf(1.f + __builtin_amdgcn_exp2f(y)); }
DI float siluf_(float x) { return x * __builtin_amdgcn_rcpf(1.f + __builtin_amdgcn_exp2f(-LOG2E * x)); }
DI float geluf_(float x) { const float u = 0.7978845608028654f * (x + 0.044715f * x * x * x); return x * __builtin_amdgcn_rcpf(1.f + __builtin_amdgcn_exp2f(-2.f * LOG2E * u)); }
DI int crow(int i, int h) { return (i & 3) + 8 * (i >> 2) + 4 * h; }
#define MFMA32(a, b, c) __builtin_amdgcn_mfma_f32_32x32x16_bf16((a), (b), (c), 0, 0, 0)
DI bf16x8 pack8(const f32x16& x, int s) {
    u32x4 p;
    p[0] = pk2(x[8 * s + 0], x[8 * s + 1]); p[1] = pk2(x[8 * s + 2], x[8 * s + 3]);
    p[2] = pk2(x[8 * s + 4], x[8 * s + 5]); p[3] = pk2(x[8 * s + 6], x[8 * s + 7]);
    return __builtin_bit_cast(bf16x8, p);
}
DI bf16x8 ld_perm(const bf16_t* p) {
    const s16x4 lo = *(const s16x4*)p, hi = *(const s16x4*)(p + 8);
    return __builtin_shufflevector(lo, hi, 0, 1, 2, 3, 4, 5, 6, 7);
}

namespace pg8 {
constexpr int BM = 256, BK = 64, HALF = 128, HTB = HALF * BK * 2, NXCD = 8, WGM = 8;
DI int lds_byte(int r, int c) { const int st = (r >> 4) * 2 + (c >> 5), rr = r & 15, cc = c & 31, ob = rr * 64 + cc * 2; return st * 1024 + (ob ^ (((ob >> 9) & 1) << 5)); }
DI void stage_rc(int b, int& R, int& C) { const int st = b / 1024, sb = b % 1024, swz = sb ^ (((sb >> 9) & 1) << 5); R = (st >> 1) * 16 + swz / 64; C = (st & 1) * 32 + (swz % 64) / 2; }
DI int perm32(int rho) { const int n = rho >> 4, i = rho & 15; return 8 * (i >> 2) + 4 * n + (i & 3); }
struct Unit { int pm, pn, z; };
struct Gemm { const bf16_t* A; const bf16_t* Bt; int lda, ldb, K, nM, nN, nZ; long zA, zB; int pn_split; int a_off2; };
struct Order {
    int nM, nN, nwg, total, G, c;
    DI void init(const Gemm& g) { nM = g.nM; nN = g.nN; nwg = nM * nN; total = nwg * g.nZ; G = gridDim.x; c = blockIdx.x; }
    DI bool next(int i, Unit& u) const {
        const long L = (long)i * G + c; if (L >= total) return false;
        u.z = (int)(L / nwg); int wgid = (int)(L % nwg);
        { const int q = nwg / NXCD, r = nwg % NXCD, xcd = wgid % NXCD, off = wgid / NXCD; wgid = (xcd < r ? xcd * (q + 1) : r * (q + 1) + (xcd - r) * q) + off; }
        const int nig = WGM * nN, gid = wgid / nig, fm = gid * WGM, gsz = (nM - fm) < WGM ? (nM - fm) : WGM;
        u.pm = fm + ((wgid % nig) % gsz); u.pn = (wgid % nig) / gsz; return true;
    }
};

template <class Epi>
DI void gemm_phase(LAS unsigned char* lds, const Gemm g, const Epi& E, const int tid) {
    const int wid = __builtin_amdgcn_readfirstlane(tid >> 6), lane = tid & 63, wr = wid >> 2, wc = wid & 3, fr = lane & 15, fq = lane >> 4;
    const int K = g.K, nt = K / BK;
    Order S; S.init(g);
    unsigned voffA[2], voffB[2];
#pragma unroll
    for (int i = 0; i < 2; ++i) { int R, C; stage_rc(tid * 16 + i * 8192, R, C); const int Rb = Epi::PERM ? ((R & ~31) + perm32(R & 31)) : R;
        voffA[i] = (unsigned)(R * g.lda + C) * 2u; voffB[i] = (unsigned)(Rb * g.ldb + C) * 2u; }
    const size_t kstep = (size_t)(BK * 2);
    const size_t hstepA = (size_t)HALF * g.lda * 2, hstepB = (size_t)HALF * g.ldb * 2;
    const unsigned ldsw = (unsigned)wid * 1024u;
    const int aoff = lds_byte(wr * 64 + fr, fq * 8), boff = lds_byte(wc * 32 + fr, fq * 8);
#define PG8_SA(b, h) (((b) * 2 + (h)) * HTB)
#define PG8_SB(b, h) ((4 + (b) * 2 + (h)) * HTB)
#define PG8_STAGE(bufoff, gbase, voff) do { _Pragma("unroll") for (int _i = 0; _i < 2; ++_i) \
        __builtin_amdgcn_global_load_lds((const unsigned*)((const char*)(gbase) + (voff)[_i]), (LAS unsigned*)(lds + (bufoff) + ldsw + _i * 8192), 16, 0, 0); } while (0)
#define PG8_LDA(dst, b, h) do { _Pragma("unroll") for (int m = 0; m < 4; ++m) _Pragma("unroll") for (int k = 0; k < 2; ++k) dst[m][k] = *(const LAS bf16x8*)(lds + PG8_SA(b, h) + aoff + m * 2048 + k * 1024); } while (0)
#define PG8_LDB(dst, b, h) do { _Pragma("unroll") for (int n = 0; n < 2; ++n) _Pragma("unroll") for (int k = 0; k < 2; ++k) dst[n][k] = *(const LAS bf16x8*)(lds + PG8_SB(b, h) + boff + n * 2048 + k * 1024); } while (0)
#define PG8_MMA(ai, bj, At, Bt) do { __builtin_amdgcn_s_setprio(1); _Pragma("unroll") for (int m = 0; m < 4; ++m) _Pragma("unroll") for (int n = 0; n < 2; ++n) _Pragma("unroll") for (int k = 0; k < 2; ++k) \
        acc[ai][bj][m][n] = __builtin_amdgcn_mfma_f32_16x16x32_bf16(Bt[n][k], At[m][k], acc[ai][bj][m][n], 0, 0, 0); __builtin_amdgcn_s_setprio(0); } while (0)
#define PG8_WAIT_V(n) asm volatile("s_waitcnt vmcnt(" #n ")" ::: "memory")
#define PG8_WAIT_L(n) asm volatile("s_waitcnt lgkmcnt(" #n ")" ::: "memory")
#define PG8_BAR __builtin_amdgcn_s_barrier()
#define PG8_SCHED __builtin_amdgcn_sched_barrier(0)
    Unit cur, nxt; int ui = 0;
    if (!S.next(0, cur)) return;
    f32x4 acc[2][2][4][2];
#pragma unroll
    for (int a = 0; a < 2; ++a)
#pragma unroll
        for (int b = 0; b < 2; ++b)
#pragma unroll
            for (int m = 0; m < 4; ++m)
#pragma unroll
                for (int n = 0; n < 2; ++n) acc[a][b][m][n] = (f32x4){0.f, 0.f, 0.f, 0.f};
    bf16x8 At[4][2], B0[2][2], B1[2][2];
    const char* cA = (const char*)g.A + (size_t)cur.z * g.zA * 2 + (size_t)cur.pm * 2 * hstepA + (cur.pn >= g.pn_split ? (size_t)g.a_off2 * 2 : (size_t)0);
    const char* cB = (const char*)g.Bt + (size_t)cur.z * g.zB * 2 + (size_t)cur.pn * 2 * hstepB;
    PG8_STAGE(PG8_SB(0, 0), cB, voffB); PG8_STAGE(PG8_SB(0, 1), cB + hstepB, voffB); PG8_STAGE(PG8_SA(0, 0), cA, voffA); PG8_STAGE(PG8_SA(0, 1), cA + hstepA, voffA);
    if (wr == 1) PG8_BAR;
    PG8_WAIT_V(2); PG8_BAR;
    PG8_STAGE(PG8_SB(1, 0), cB + kstep, voffB); PG8_STAGE(PG8_SA(1, 0), cA + kstep, voffA); PG8_STAGE(PG8_SB(1, 1), cB + hstepB + kstep, voffB);
    PG8_WAIT_V(6); PG8_BAR;
    for (;;) {
        const bool has_next = S.next(ui + 1, nxt);
        const char* nA = has_next ? (const char*)g.A + (size_t)nxt.z * g.zA * 2 + (size_t)nxt.pm * 2 * hstepA + (nxt.pn >= g.pn_split ? (size_t)g.a_off2 * 2 : (size_t)0) : cA;
        const char* nB = has_next ? (const char*)g.Bt + (size_t)nxt.z * g.zB * 2 + (size_t)nxt.pn * 2 * hstepB : cB;
#pragma clang loop unroll(disable)
        for (int t = 0; t < nt; t += 2) {
            const bool last = (t == nt - 2);
            const char* a1 = cA + (size_t)(t + 1) * kstep;
            const char* a2 = last ? nA : cA + (size_t)(t + 2) * kstep; const char* b2 = last ? nB : cB + (size_t)(t + 2) * kstep;
            const char* a3 = a2 + kstep; const char* b3 = b2 + kstep;
            PG8_LDB(B0, 0, 0); PG8_LDB(B1, 0, 1); PG8_SCHED; PG8_LDA(At, 0, 0); PG8_STAGE(PG8_SA(1, 1), a1 + hstepA, voffA);
            PG8_WAIT_V(8); PG8_WAIT_L(0); PG8_BAR; PG8_MMA(0, 0, At, B0); PG8_MMA(0, 1, At, B1); PG8_BAR; PG8_SCHED;
            PG8_LDA(At, 0, 1); PG8_STAGE(PG8_SB(0, 0), b2, voffB); PG8_STAGE(PG8_SB(0, 1), b2 + hstepB, voffB); PG8_STAGE(PG8_SA(0, 0), a2, voffA);
            PG8_WAIT_V(8); PG8_WAIT_L(0); PG8_BAR; PG8_MMA(1, 0, At, B0); PG8_MMA(1, 1, At, B1); PG8_BAR; PG8_SCHED;
            PG8_LDB(B0, 1, 0); PG8_LDB(B1, 1, 1); PG8_SCHED; PG8_LDA(At, 1, 0); PG8_STAGE(PG8_SA(0, 1), a2 + hstepA, voffA);
            PG8_WAIT_V(8); PG8_WAIT_L(0); PG8_BAR; PG8_MMA(0, 0, At, B0); PG8_MMA(0, 1, At, B1); PG8_BAR; PG8_SCHED;
            PG8_LDA(At, 1, 1); PG8_STAGE(PG8_SB(1, 0), b3, voffB); PG8_STAGE(PG8_SB(1, 1), b3 + hstepB, voffB); PG8_STAGE(PG8_SA(1, 0), a3, voffA);
            PG8_WAIT_V(8); PG8_WAIT_L(0); PG8_BAR; PG8_MMA(1, 0, At, B0); PG8_MMA(1, 1, At, B1); PG8_BAR; PG8_SCHED;
        }
        if (wr == 0) PG8_BAR;
        E(acc, cur, wr, wc, fr, fq);
        if (!has_next) break;
#pragma unroll
        for (int a = 0; a < 2; ++a)
#pragma unroll
            for (int b = 0; b < 2; ++b)
#pragma unroll
                for (int m = 0; m < 4; ++m)
#pragma unroll
                    for (int n = 0; n < 2; ++n) acc[a][b][m][n] = (f32x4){0.f, 0.f, 0.f, 0.f};
        cur = nxt; cA = nA; cB = nB; ++ui;
        if (wr == 1) PG8_BAR;
    }
    PG8_WAIT_V(0);
    PG8_BAR;
#undef PG8_SA
#undef PG8_SB
#undef PG8_STAGE
#undef PG8_LDA
#undef PG8_LDB
#undef PG8_MMA
#undef PG8_WAIT_V
#undef PG8_WAIT_L
#undef PG8_BAR
#undef PG8_SCHED
}

struct EpiProj {
    static constexpr bool PERM = true;
    bf16_t* proj; float* small;
    DI void operator()(const f32x4 (&acc)[2][2][4][2], const Unit& u, int wr, int wc, int fr, int fq) const {
        const int row0 = u.pm * BM + wr * 64 + fr, colb = u.pn * BM + wc * 32 + 8 * fq;
#pragma unroll
        for (int ai = 0; ai < 2; ++ai)
#pragma unroll
            for (int m = 0; m < 4; ++m) { const size_t row = (size_t)(row0 + ai * HALF + m * 16);
#pragma unroll
                for (int bj = 0; bj < 2; ++bj) { const int col = colb + bj * HALF; const f32x4 v0 = acc[ai][bj][m][0], v1 = acc[ai][bj][m][1];
                    if (col < PLD) { u32x4 o; o[0] = pk2(v0[0], v0[1]); o[1] = pk2(v0[2], v0[3]); o[2] = pk2(v1[0], v1[1]); o[3] = pk2(v1[2], v1[3]); *(u32x4*)(proj + row * PLD + col) = o; }
                    else if (col < PLD + 16) { float* sp = small + row * 16 + (col - PLD); *(f32x4*)sp = v0; *(f32x4*)(sp + 4) = v1; } } }
    }
};
template <int ACT> struct EpiBf16 {
    static constexpr bool PERM = true;
    bf16_t* O; int ldc; int zc;
    DI void operator()(const f32x4 (&acc)[2][2][4][2], const Unit& u, int wr, int wc, int fr, int fq) const {
        const int row0 = u.pm * BM + wr * 64 + fr, colb = u.z * zc + u.pn * BM + wc * 32 + 8 * fq;
#pragma unroll
        for (int ai = 0; ai < 2; ++ai)
#pragma unroll
            for (int m = 0; m < 4; ++m) { const size_t row = (size_t)(row0 + ai * HALF + m * 16);
#pragma unroll
                for (int bj = 0; bj < 2; ++bj) { f32x4 v0 = acc[ai][bj][m][0], v1 = acc[ai][bj][m][1];
                    if (ACT == 1) {
#pragma unroll
                        for (int j = 0; j < 4; ++j) { const float a = fmaxf(v0[j], 0.f), b = fmaxf(v1[j], 0.f); v0[j] = a * a; v1[j] = b * b; } }
                    u32x4 o; o[0] = pk2(v0[0], v0[1]); o[1] = pk2(v0[2], v0[3]); o[2] = pk2(v1[0], v1[1]); o[3] = pk2(v1[2], v1[3]);
                    *(u32x4*)(O + row * ldc + colb + bj * HALF) = o; } }
    }
};
struct EpiResid {
    static constexpr bool PERM = false;
    float* dst; const float* src;
    DI void operator()(const f32x4 (&acc)[2][2][4][2], const Unit& u, int wr, int wc, int fr, int fq) const {
        const int row0 = u.pm * BM + wr * 64 + fr, col0 = u.pn * BM + wc * 32 + 4 * fq;
#pragma unroll
        for (int ai = 0; ai < 2; ++ai)
#pragma unroll
            for (int mp = 0; mp < 2; ++mp) {
                f32x4 sv[2][2][2];
#pragma unroll
                for (int mm = 0; mm < 2; ++mm)
#pragma unroll
                    for (int bj = 0; bj < 2; ++bj)
#pragma unroll
                        for (int n = 0; n < 2; ++n) sv[mm][bj][n] = *(const f32x4*)(src + (size_t)(row0 + ai * HALF + (2 * mp + mm) * 16) * 1024 + col0 + bj * HALF + n * 16);
                __builtin_amdgcn_sched_barrier(0);
#pragma unroll
                for (int mm = 0; mm < 2; ++mm)
#pragma unroll
                    for (int bj = 0; bj < 2; ++bj)
#pragma unroll
                        for (int n = 0; n < 2; ++n) *(f32x4*)(dst + (size_t)(row0 + ai * HALF + (2 * mp + mm) * 16) * 1024 + col0 + bj * HALF + n * 16) = sv[mm][bj][n] + acc[ai][bj][2 * mp + mm][n];
                __builtin_amdgcn_sched_barrier(0);
            }
    }
};
struct EpiMerge {
    static constexpr bool PERM = false;
    const bf16_t* P; bf16_t* merged;
    DI void operator()(const f32x4 (&acc)[2][2][4][2], const Unit& u, int wr, int wc, int fr, int fq) const {
        const int row0 = u.pm * BM + wr * 64 + fr, d0 = u.pn * 64 + wc * 16 + 4 * fq;
#pragma unroll
        for (int ai = 0; ai < 2; ++ai) {
            u32x2 pv[4][4];
#pragma unroll
            for (int m = 0; m < 4; ++m)
#pragma unroll
                for (int j = 0; j < 4; ++j) pv[m][j] = *(const u32x2*)(P + (size_t)(row0 + ai * HALF + m * 16) * 4096 + j * 1024 + d0);
            __builtin_amdgcn_sched_barrier(0);
#pragma unroll
            for (int m = 0; m < 4; ++m) { const size_t row = (size_t)(row0 + ai * HALF + m * 16);
                float o[4] = {0.f, 0.f, 0.f, 0.f};
#pragma unroll
                for (int j = 0; j < 4; ++j) { const u32x2 pw = pv[m][j];
                    const float p0 = __uint_as_float(pw[0] << 16), p1 = __uint_as_float(pw[0] & 0xffff0000u), p2 = __uint_as_float(pw[1] << 16), p3 = __uint_as_float(pw[1] & 0xffff0000u);
                    o[0] += sigp_(acc[ai][0][m][0][j]) * p0; o[1] += sigp_(acc[ai][0][m][1][j]) * p1;
                    o[2] += sigp_(acc[ai][1][m][0][j]) * p2; o[3] += sigp_(acc[ai][1][m][1][j]) * p3; }
                u32x2 ov; ov[0] = pk2(o[0], o[1]); ov[1] = pk2(o[2], o[3]);
                *(u32x2*)(merged + row * 1024 + d0) = ov; }
            __builtin_amdgcn_sched_barrier(0);
        }
    }
};
}

template <class F>
DI void convert_mat(bf16_t* dst, int N, int Kd, F elem, float* tl, const int tid) {
    const int ntn = N / 64, ntk = Kd / 64, nt = ntn * ntk;
    float v[8];
    int tile = blockIdx.x;
    if (tile < nt) { const int tn = tile % ntn, tk = tile / ntn;
#pragma unroll
        for (int e = 0; e < 8; ++e) { const int idx = tid + e * NTHR; v[e] = elem(tn * 64 + (idx & 63), tk * 64 + (idx >> 6)); } }
    for (; tile < nt; tile += gridDim.x) {
        const int tn = tile % ntn, tk = tile / ntn;
        __syncthreads();
#pragma unroll
        for (int e = 0; e < 8; ++e) { const int idx = tid + e * NTHR; tl[(idx >> 6) * 65 + (idx & 63)] = v[e]; }
        __syncthreads();
        { const int nx = tile + gridDim.x; if (nx < nt) { const int tn2 = nx % ntn, tk2 = nx / ntn;
#pragma unroll
            for (int e = 0; e < 8; ++e) { const int idx = tid + e * NTHR; v[e] = elem(tn2 * 64 + (idx & 63), tk2 * 64 + (idx >> 6)); } } }
#pragma unroll
        for (int e = 0; e < 4; ++e) { const int idx = tid + e * NTHR; const int n = idx >> 5, k2 = (idx & 31) * 2;
            *(unsigned*)(dst + (size_t)(tn * 64 + n) * Kd + tk * 64 + k2) = pk2(tl[k2 * 65 + n], tl[(k2 + 1) * 65 + n]); }
    }
}

DI void rmsnorm_phase(const float* x, const float* g, bf16_t* h, int ntok, const int tid) {
    const int lane = tid & 63, wv = tid >> 6;
    f32x4 gg[4];
#pragma unroll
    for (int c = 0; c < 4; ++c) gg[c] = ((const f32x4*)g)[lane + 64 * c];
    for (int t0 = (blockIdx.x * 8 + wv) * 2; t0 < ntok; t0 += gridDim.x * 16) {
        f32x4 v[2][4];
#pragma unroll
        for (int u = 0; u < 2; ++u)
#pragma unroll
            for (int c = 0; c < 4; ++c) v[u][c] = ((const f32x4*)(x + (size_t)(t0 + u) * 1024))[lane + 64 * c];
#pragma unroll
        for (int u = 0; u < 2; ++u) { float ss = 0.f;
#pragma unroll
            for (int c = 0; c < 4; ++c) ss += v[u][c][0] * v[u][c][0] + v[u][c][1] * v[u][c][1] + v[u][c][2] * v[u][c][2] + v[u][c][3] * v[u][c][3];
            ss = wave_sum(ss);
            const float rs = rsqrtf(ss * (1.f / 1024.f) + NEPS);
#pragma unroll
            for (int c = 0; c < 4; ++c) { u32x2 o; o[0] = pk2(v[u][c][0] * rs * gg[c][0], v[u][c][1] * rs * gg[c][1]); o[1] = pk2(v[u][c][2] * rs * gg[c][2], v[u][c][3] * rs * gg[c][3]);
                *(u32x2*)(h + (size_t)(t0 + u) * 1024 + (lane + 64 * c) * 4) = o; } }
    }
}

DI void transpose_v_item(const bf16_t* src, int ld, bf16_t* vt, int s0, bf16_t* ts  , const int tid) {
    __syncthreads();
    { const int row = tid >> 3, seg = tid & 7; const u32x4 a = *(const u32x4*)(src + (size_t)row * ld + seg * 16), b = *(const u32x4*)(src + (size_t)row * ld + seg * 16 + 8);
      unsigned* d = (unsigned*)(ts + row * 130 + seg * 16);
      d[0] = a[0]; d[1] = a[1]; d[2] = a[2]; d[3] = a[3]; d[4] = b[0]; d[5] = b[1]; d[6] = b[2]; d[7] = b[3]; }
    __syncthreads();
    { const int dv = tid >> 2, part = tid & 3; u32x4 o0, o1;
#pragma unroll
      for (int e = 0; e < 4; ++e) { o0[e] = (unsigned)ts[(part * 16 + 2 * e) * 130 + dv] | ((unsigned)ts[(part * 16 + 2 * e + 1) * 130 + dv] << 16);
                                    o1[e] = (unsigned)ts[(part * 16 + 8 + 2 * e) * 130 + dv] | ((unsigned)ts[(part * 16 + 8 + 2 * e + 1) * 130 + dv] << 16); }
      bf16_t* d = vt + (size_t)dv * SEQ + s0 + part * 16; *(u32x4*)d = o0; *(u32x4*)(d + 8) = o1; }
}

DI void transpose_v_phase(const bf16_t* base, int ld, int col0, int colh, bf16_t* vtbase, bf16_t* ts  , const int tid) {
    const int row = tid >> 3, seg = tid & 7, dv = tid >> 2, part = tid & 3;
    int it = blockIdx.x; u32x4 pa, pb;
    if (it < 2048) { const int sti = it & 63, h = (it >> 6) & 3, b = it >> 8; const bf16_t* src = base + (size_t)(b * SEQ + sti * 64 + row) * ld + col0 + h * colh + seg * 16;
        pa = *(const u32x4*)src; pb = *(const u32x4*)(src + 8); }
    for (; it < 2048; it += gridDim.x) {
        const int sti = it & 63, h = (it >> 6) & 3, b = it >> 8;
        __syncthreads();
        { unsigned* d = (unsigned*)(ts + row * 130 + seg * 16); d[0] = pa[0]; d[1] = pa[1]; d[2] = pa[2]; d[3] = pa[3]; d[4] = pb[0]; d[5] = pb[1]; d[6] = pb[2]; d[7] = pb[3]; }
        __syncthreads();
        { const int nx = it + gridDim.x; if (nx < 2048) { const int sti2 = nx & 63, h2 = (nx >> 6) & 3, b2 = nx >> 8; const bf16_t* src = base + (size_t)(b2 * SEQ + sti2 * 64 + row) * ld + col0 + h2 * colh + seg * 16;
            pa = *(const u32x4*)src; pb = *(const u32x4*)(src + 8); } }
        u32x4 o0, o1;
#pragma unroll
        for (int e = 0; e < 4; ++e) { o0[e] = (unsigned)ts[(part * 16 + 2 * e) * 130 + dv] | ((unsigned)ts[(part * 16 + 2 * e + 1) * 130 + dv] << 16);
                                      o1[e] = (unsigned)ts[(part * 16 + 8 + 2 * e) * 130 + dv] | ((unsigned)ts[(part * 16 + 8 + 2 * e + 1) * 130 + dv] << 16); }
        bf16_t* d = vtbase + (size_t)(b * 4 + h) * 128 * SEQ + (size_t)dv * SEQ + sti * 64 + part * 16; *(u32x4*)d = o0; *(u32x4*)(d + 8) = o1;
    }
}

struct DnPrepArgs { const bf16_t* proj; const float* small; const float* convw; const float* alog; const float* dtb;
                    bf16_t *qdec, *negw, *u, *kdT, *aqk; float* glast; };
DI void dn_prep_item(int item, const DnPrepArgs& a, unsigned char* smem, const int tid, const int lim = 9) {
    const int lane = tid & 63, wv = tid >> 6;
    const int bh = item >> 6, n = item & 63, b = bh >> 2, h = bh & 3;
    const int t0 = b * SEQ + n * 64, s0 = n * 64;
    bf16_t* RT = (bf16_t*)smem;
    float* R1 = (float*)(smem + 36864);
    bf16_t* qs = (bf16_t*)(smem + 69632);
    bf16_t* ks = (bf16_t*)(smem + 87040);
    float* Lm = (float*)(smem + 104448);
    float* Tm = (float*)(smem + 121856);
    float* tmp = (float*)(smem + 139264);
    bf16_t* Tb = (bf16_t*)(smem + 143488);
    float* gcs = (float*)(smem + 152704); float* betas = gcs + 64; float* egs = gcs + 128;
    float xr[3][19];
    { const int seg = tid >> 7, c = tid & 127, tt0 = seg * 16;
#pragma unroll
      for (int part = 0; part < 3; ++part) { const bf16_t* src = a.proj + (size_t)t0 * PLD + part * 512 + h * 128 + c;
#pragma unroll
          for (int e = 0; e < 19; ++e) { const int ti = tt0 + e - 3; const bool ok = (s0 + ti >= 0); const float vv = bf2f(src[(long)(ok ? ti : 0) * PLD]); xr[part][e] = ok ? vv : 0.f; } } }
    __syncthreads();
    if (tid < 64) {
        const float al = a.small[(size_t)(t0 + tid) * 16 + h], bl = a.small[(size_t)(t0 + tid) * 16 + 4 + h];
        const float xx = al + a.dtb[h]; const float sp = xx > 20.f ? xx : log1pf(__expf(xx));
        float g = -__expf(a.alog[h]) * sp;
        for (int o = 1; o < 64; o <<= 1) { const float t = __shfl_up(g, o); if (lane >= o) g += t; }
        gcs[tid] = g; betas[tid] = sigmoidf_(bl); egs[tid] = __expf(g);
    }
    for (int e = tid; e < 64 * 68; e += NTHR) Tm[e] = 0.f;
    __syncthreads();
    {
        const int seg = tid >> 7, c = tid & 127, tt0 = seg * 16;
        float y[3][16];
#pragma unroll
        for (int part = 0; part < 3; ++part) { const int col = part * 512 + h * 128 + c;
            const float w0 = a.convw[col], w1 = a.convw[1536 + col], w2 = a.convw[2 * 1536 + col], w3 = a.convw[3 * 1536 + col];
#pragma unroll
            for (int e = 0; e < 16; ++e) y[part][e] = siluf_(w0 * xr[part][e] + w1 * xr[part][e + 1] + w2 * xr[part][e + 2] + w3 * xr[part][e + 3]); }
        float* ssq = R1;
#pragma unroll
        for (int part = 0; part < 2; ++part) {
            float v[16];
#pragma unroll
            for (int e = 0; e < 16; ++e) v[e] = y[part][e] * y[part][e];
#define TR_STEP(o, n) { const bool up = (lane & (o)) != 0; _Pragma("unroll") for (int i = 0; i < (n) / 2; ++i) { const float av = v[i], bv = v[i + (n) / 2]; const float snd = up ? av : bv, kp = up ? bv : av; v[i] = kp + __shfl_xor(snd, (o)); } }
            TR_STEP(1, 16) TR_STEP(2, 8) TR_STEP(4, 4) TR_STEP(8, 2)
#undef TR_STEP
            float tot = v[0]; tot += __shfl_xor(tot, 16); tot += __shfl_xor(tot, 32);
            if (lane < 16) { const int e = ((lane & 1) << 3) | ((lane & 2) << 1) | ((lane & 4) >> 1) | ((lane & 8) >> 3); ssq[(part * 64 + tt0 + e) * 2 + (wv & 1)] = tot; }
        }
        __syncthreads();
        float rk_[16], rv_[16];
#pragma unroll
        for (int e = 0; e < 16; ++e) { const int tt = tt0 + e;
            const float rq = rsqrtf(ssq[tt * 2] + ssq[tt * 2 + 1] + NEPS) * 0.08838834764831845f, rk = rsqrtf(ssq[(64 + tt) * 2] + ssq[(64 + tt) * 2 + 1] + NEPS);
            const float bt = betas[tt];
            qs[tt * 136 + c] = f2bf(y[0][e] * rq);
            const float kn = y[1][e] * rk; ks[tt * 136 + c] = f2bf(kn);
            rk_[e] = kn * bt * egs[tt]; rv_[e] = y[2][e] * bt; }
        u32x4 o0, o1;
#pragma unroll
        for (int e = 0; e < 4; ++e) { o0[e] = pk2(rk_[2 * e], rk_[2 * e + 1]); o1[e] = pk2(rk_[8 + 2 * e], rk_[8 + 2 * e + 1]); }
        *(u32x4*)(RT + (128 + c) * 72 + tt0) = o0; *(u32x4*)(RT + (128 + c) * 72 + tt0 + 8) = o1;
#pragma unroll
        for (int e = 0; e < 4; ++e) { o0[e] = pk2(rv_[2 * e], rv_[2 * e + 1]); o1[e] = pk2(rv_[8 + 2 * e], rv_[8 + 2 * e + 1]); }
        *(u32x4*)(RT + c * 72 + tt0) = o0; *(u32x4*)(RT + c * 72 + tt0 + 8) = o1;
    }
    __syncthreads();
    if (lim <= 1) return;
    {
        const int r = lane & 31, h2 = lane >> 5, w4 = wv & 3, ib = w4 >> 1, jb = w4 & 1;
        const bf16_t* Am = (wv < 4) ? ks : qs;
        f32x16 acc; for (int i = 0; i < 16; ++i) acc[i] = 0.f;
#pragma unroll
        for (int s = 0; s < 8; ++s) { const bf16x8 av = *(const bf16x8*)(Am + (32 * ib + r) * 136 + 16 * s + 8 * h2), bv = *(const bf16x8*)(ks + (32 * jb + r) * 136 + 16 * s + 8 * h2);
            acc = MFMA32(av, bv, acc); }
        const int j = 32 * jb + r; const float gj = gcs[j];
        bf16_t* aq = a.aqk + (size_t)item * 4096;
#pragma unroll
        for (int i2 = 0; i2 < 16; ++i2) { const int i = 32 * ib + crow(i2, h2); const float gi = gcs[i];
            if (wv < 4) { Lm[i * 68 + j] = (j < i) ? betas[i] * acc[i2] * __expf(gi - gj) : 0.f; }
            else { aq[i * 64 + j] = f2bf((j <= i) ? acc[i2] * __expf(gi - gj) : 0.f); } }
    }
    __syncthreads();
    if (lim <= 2) return;
    if (tid < 64) { const int ab = tid >> 4, c = tid & 15; float x[16];
#pragma unroll
        for (int i = 0; i < 16; ++i) { float sv = (i == c) ? 1.f : 0.f;
#pragma unroll
            for (int jx = 0; jx < i; ++jx) sv -= Lm[(16 * ab + i) * 68 + 16 * ab + jx] * x[jx];
            x[i] = sv; }
#pragma unroll
        for (int i = 0; i < 16; ++i) Tm[(16 * ab + i) * 68 + 16 * ab + c] = x[i]; }
    __syncthreads();
    { const int pp = tid >> 8, i = (tid >> 4) & 15, jx = tid & 15; float sv = 0.f;
#pragma unroll
      for (int k = 0; k < 16; ++k) sv += Lm[(32 * pp + 16 + i) * 68 + 32 * pp + k] * Tm[(32 * pp + k) * 68 + 32 * pp + jx];
      tmp[(pp * 16 + i) * 33 + jx] = sv; }
    __syncthreads();
    { const int pp = tid >> 8, i = (tid >> 4) & 15, jx = tid & 15; float sv = 0.f;
#pragma unroll
      for (int k = 0; k < 16; ++k) sv += Tm[(32 * pp + 16 + i) * 68 + 32 * pp + 16 + k] * tmp[(pp * 16 + k) * 33 + jx];
      __syncthreads();
      Tm[(32 * pp + 16 + i) * 68 + 32 * pp + jx] = -sv; }
    __syncthreads();
    { const int i = tid >> 4, j0 = (tid & 15) * 2; float s0v = 0.f, s1v = 0.f;
#pragma unroll 8
      for (int k = 0; k < 32; ++k) { const float lv = Lm[(32 + i) * 68 + k]; s0v += lv * Tm[k * 68 + j0]; s1v += lv * Tm[k * 68 + j0 + 1]; }
      tmp[i * 33 + j0] = s0v; tmp[i * 33 + j0 + 1] = s1v; }
    __syncthreads();
    { const int i = tid >> 4, j0 = (tid & 15) * 2; float s0v = 0.f, s1v = 0.f;
#pragma unroll 8
      for (int k = 0; k < 32; ++k) { const float tv = Tm[(32 + i) * 68 + 32 + k]; s0v += tv * tmp[k * 33 + j0]; s1v += tv * tmp[k * 33 + j0 + 1]; }
      Tm[(32 + i) * 68 + j0] = -s0v; Tm[(32 + i) * 68 + j0 + 1] = -s1v; }
    __syncthreads();
#pragma unroll
    for (int e = 0; e < 8; ++e) { const int idx = tid + e * NTHR, i = idx >> 6, jx = idx & 63; Tb[i * 72 + jx] = f2bf(Tm[i * 68 + jx]); }
    __syncthreads();
    if (lim <= 3) return;
    {
        const int r = lane & 31, h2 = lane >> 5;
#pragma unroll
        for (int ib = 0; ib < 2; ++ib) {
            f32x16 acc; for (int i = 0; i < 16; ++i) acc[i] = 0.f;
#pragma unroll
            for (int s = 0; s < 4; ++s) acc = MFMA32(*(const bf16x8*)(Tb + (32 * ib + r) * 72 + 16 * s + 8 * h2), *(const bf16x8*)(RT + (32 * wv + r) * 72 + 16 * s + 8 * h2), acc);
            bf16_t* dst = ((wv < 4) ? a.u : a.negw) + (size_t)item * 8192 + 32 * (wv & 3) + r; const float sg = (wv < 4) ? 1.f : -1.f;
#pragma unroll
            for (int i2 = 0; i2 < 16; ++i2) dst[(32 * ib + crow(i2, h2)) * 128] = f2bf(sg * acc[i2]);
        }
    }
    {
        const int tt = tid >> 3, seg = tid & 7; const float eg = __expf(gcs[tt]);
        u32x4 o0, o1;
        const bf16_t* qr = qs + tt * 136 + seg * 16;
#pragma unroll
        for (int e = 0; e < 4; ++e) { o0[e] = pk2(bf2f(qr[2 * e]) * eg, bf2f(qr[2 * e + 1]) * eg); o1[e] = pk2(bf2f(qr[8 + 2 * e]) * eg, bf2f(qr[8 + 2 * e + 1]) * eg); }
        bf16_t* d = a.qdec + (size_t)item * 8192 + tt * 128 + seg * 16; *(u32x4*)d = o0; *(u32x4*)(d + 8) = o1;
        const int dk = tid >> 2, part = tid & 3; const float gl = gcs[63];
#pragma unroll
        for (int e = 0; e < 4; ++e) { const int ta = part * 16 + 2 * e, tb = part * 16 + 8 + 2 * e;
            o0[e] = pk2(bf2f(ks[ta * 136 + dk]) * __expf(gl - gcs[ta]), bf2f(ks[(ta + 1) * 136 + dk]) * __expf(gl - gcs[ta + 1]));
            o1[e] = pk2(bf2f(ks[tb * 136 + dk]) * __expf(gl - gcs[tb]), bf2f(ks[(tb + 1) * 136 + dk]) * __expf(gl - gcs[tb + 1])); }
        d = a.kdT + (size_t)item * 8192 + dk * 64 + part * 16; *(u32x4*)d = o0; *(u32x4*)(d + 8) = o1;
        if (tid == 0) a.glast[item] = __expf(gl);
    }
}

struct DnScanArgs { const bf16_t *qdec, *negw, *u, *kdT, *aqk; const float* glast; bf16_t* obuf; const bf16_t* proj; const float* og; };
DI void dn_scan_item(int bh, const DnScanArgs& a, unsigned char* smem, const int tid) {
    const int lane = tid & 63, wv = tid >> 6, r = lane & 31, h2 = lane >> 5;
    const int b = bh >> 2, h = bh & 3;
    constexpr int BUFB = (3 * 64 * 136 + 64 * 72 + 128 * 72) * 2;
    __syncthreads();
#define DN_LOAD(n_) do { const size_t item_ = (size_t)bh * 64 + (n_); bf16_t* sW_ = (bf16_t*)(smem + ((n_) & 1) * BUFB); bf16_t* sQ_ = sW_ + 64 * 136; bf16_t* sU_ = sQ_ + 64 * 136; bf16_t* sA_ = sU_ + 64 * 136; bf16_t* sK_ = sA_ + 64 * 72; \
        const int lt_ = tid - 256; u32x4 w_[4], q_[4], u_[4], k_[4], a_[2]; \
        _Pragma("unroll") for (int i = 0; i < 4; ++i) { const int c = lt_ + 256 * i; const size_t o = item_ * 8192 + (size_t)(c >> 4) * 128 + (c & 15) * 8; \
            w_[i] = *(const u32x4*)(a.negw + o); q_[i] = *(const u32x4*)(a.qdec + o); u_[i] = *(const u32x4*)(a.u + o); k_[i] = *(const u32x4*)(a.kdT + item_ * 8192 + (size_t)(c >> 3) * 64 + (c & 7) * 8); } \
        _Pragma("unroll") for (int i = 0; i < 2; ++i) { const int c = lt_ + 256 * i; a_[i] = *(const u32x4*)(a.aqk + item_ * 4096 + (size_t)(c >> 3) * 64 + (c & 7) * 8); } \
        _Pragma("unroll") for (int i = 0; i < 4; ++i) { const int c = lt_ + 256 * i; const int o = (c >> 4) * 136 + (c & 15) * 8; \
            *(u32x4*)(sW_ + o) = w_[i]; *(u32x4*)(sQ_ + o) = q_[i]; *(u32x4*)(sU_ + o) = u_[i]; *(u32x4*)(sK_ + (c >> 3) * 72 + (c & 7) * 8) = k_[i]; } \
        _Pragma("unroll") for (int i = 0; i < 2; ++i) { const int c = lt_ + 256 * i; *(u32x4*)(sA_ + (c >> 3) * 72 + (c & 7) * 8) = a_[i]; } } while (0)
    if (wv >= 4) DN_LOAD(0);
    __syncthreads();
    if (wv >= 4) {
        const float og0 = a.og[2 * lane], og1 = a.og[2 * lane + 1];
#define DN_POST(c_) do { const size_t row0_ = (size_t)b * SEQ + (size_t)(c_) * 64 + (wv - 4) * 16; unsigned vo_[16], vz_[16]; \
        _Pragma("unroll") for (int e = 0; e < 16; ++e) { vo_[e] = *(const unsigned*)(a.obuf + (row0_ + e) * 2048 + h * 128 + 2 * lane); vz_[e] = *(const unsigned*)(a.proj + (row0_ + e) * PLD + 1536 + h * 128 + 2 * lane); } \
        _Pragma("unroll") for (int e = 0; e < 16; ++e) { const float a0 = __uint_as_float(vo_[e] << 16), a1 = __uint_as_float(vo_[e] & 0xffff0000u); \
            const float rs = rsqrtf(wave_sum(a0 * a0 + a1 * a1) * (1.f / 128.f) + NEPS); const float z0 = __uint_as_float(vz_[e] << 16), z1 = __uint_as_float(vz_[e] & 0xffff0000u); \
            *(unsigned*)(a.obuf + (row0_ + e) * 2048 + h * 128 + 2 * lane) = pk2(a0 * rs * og0 * siluf_(z0), a1 * rs * og1 * siluf_(z1)); } } while (0)
        for (int n = 0; n < 64; ++n) { if (n + 1 < 64) DN_LOAD(n + 1); if (n >= 1) DN_POST(n - 1); __syncthreads(); }
        DN_POST(63);
#undef DN_POST
    } else {
        f32x16 S[4];
#pragma unroll
        for (int k = 0; k < 4; ++k) for (int i = 0; i < 16; ++i) S[k][i] = 0.f;
        bf16x8 If[2];
#pragma unroll
        for (int s = 0; s < 2; ++s) for (int j = 0; j < 8; ++j) If[s][j] = ((16 * s + 8 * (j >> 2) + 4 * h2 + (j & 3)) == r) ? (short)0x3F80 : (short)0;
        float gl_next = a.glast[(size_t)bh * 64];
        for (int n = 0; n < 64; ++n) {
            const float gl = gl_next; gl_next = a.glast[(size_t)bh * 64 + ((n + 1 < 64) ? n + 1 : n)];
            const bf16_t* sW = (const bf16_t*)(smem + (n & 1) * BUFB); const bf16_t* sQ = sW + 64 * 136; const bf16_t* sU = sQ + 64 * 136; const bf16_t* sA = sU + 64 * 136; const bf16_t* sK = sA + 64 * 72;
            bf16x8 Sf[4][2];
#pragma unroll
            for (int kb = 0; kb < 4; ++kb) { Sf[kb][0] = pack8(S[kb], 0); Sf[kb][1] = pack8(S[kb], 1); }
            bf16x8 Vf[2][2];
#pragma unroll
            for (int tb = 0; tb < 2; ++tb) {
                f32x16 acc; for (int i = 0; i < 16; ++i) acc[i] = 0.f;
#pragma unroll
                for (int kb = 0; kb < 4; ++kb)
#pragma unroll
                    for (int s = 0; s < 2; ++s) acc = MFMA32(ld_perm(sW + (32 * tb + r) * 136 + 32 * kb + 16 * s + 4 * h2), Sf[kb][s], acc);
#pragma unroll
                for (int s = 0; s < 2; ++s) acc = MFMA32(ld_perm(sU + (32 * tb + r) * 136 + 32 * wv + 16 * s + 4 * h2), If[s], acc);
                Vf[tb][0] = pack8(acc, 0); Vf[tb][1] = pack8(acc, 1);
            }
#pragma unroll
            for (int ib = 0; ib < 2; ++ib) {
                f32x16 acc; for (int i = 0; i < 16; ++i) acc[i] = 0.f;
#pragma unroll
                for (int kb = 0; kb < 4; ++kb)
#pragma unroll
                    for (int s = 0; s < 2; ++s) acc = MFMA32(ld_perm(sQ + (32 * ib + r) * 136 + 32 * kb + 16 * s + 4 * h2), Sf[kb][s], acc);
#pragma unroll
                for (int tb = 0; tb < 2; ++tb)
#pragma unroll
                    for (int s = 0; s < 2; ++s) acc = MFMA32(ld_perm(sA + (32 * ib + r) * 72 + 32 * tb + 16 * s + 4 * h2), Vf[tb][s], acc);
                bf16_t* op = a.obuf + (size_t)(b * SEQ + n * 64 + 32 * ib) * 2048 + h * 128 + 32 * wv + r;
#pragma unroll
                for (int i = 0; i < 16; ++i) op[(size_t)crow(i, h2) * 2048] = f2bf(acc[i]);
            }
#pragma unroll
            for (int kb = 0; kb < 4; ++kb) {
                f32x16 acc = S[kb];
#pragma unroll
                for (int i = 0; i < 16; ++i) acc[i] *= gl;
#pragma unroll
                for (int tb = 0; tb < 2; ++tb)
#pragma unroll
                    for (int s = 0; s < 2; ++s) acc = MFMA32(ld_perm(sK + (32 * kb + r) * 72 + 32 * tb + 16 * s + 4 * h2), Vf[tb][s], acc);
                S[kb] = acc;
            }
            __syncthreads();
        }
    }
#undef DN_LOAD
}

template <int DK, bool DECAY>
DI void attn_item(const bf16_t* Q, int ldq, const bf16_t* Kp, int ldk, const bf16_t* Vt, const float* cum, bf16_t* O, int ldo, int qt, float m0, unsigned char* smem, const int tid, const int rep = 0) {
    const int amode = rep ? PROBE_SUB : 0;
    constexpr int KLD = DK + 8, NKC = DK / 8, NKL = (64 * NKC) / NTHR, KS = DK / 16, VLD = 68;
    constexpr int STAGE = 64 * KLD * 2 + 128 * VLD * 2 + 256;
    const int lane = tid & 63, wv = tid >> 6, r = lane & 31, h2 = lane >> 5;
    const int q0 = qt * 256 + wv * 32;
    bf16x8 qf[KS];
#pragma unroll
    for (int ks = 0; ks < KS; ++ks) qf[ks] = *(const bf16x8*)(Q + (size_t)(q0 + r) * ldq + 16 * ks + 8 * h2);
    f32x16 oacc[4];
#pragma unroll
    for (int d = 0; d < 4; ++d) for (int i = 0; i < 16; ++i) oacc[d][i] = 0.f;
    float l_run = 0.f;
    const float c0 = (DECAY ? cum[q0 + r] * LOG2E : 0.f) - m0;
    const int ntiles = (qt + 1) * 4;
    u32x4 pk_[NKL], pv_[2]; float pc_ = 0.f;
#define ATT_ISSUE_K(j_) do { const int k0_ = (j_) * 64; \
        _Pragma("unroll") for (int i = 0; i < NKL; ++i) { const int c = tid + i * NTHR, row = c / NKC, cc = c % NKC; pk_[i] = *(const u32x4*)(Kp + (size_t)(k0_ + row) * ldk + cc * 8); } \
        if (DECAY && tid < 64) pc_ = cum[k0_ + tid] * LOG2E; } while (0)
#define ATT_ISSUE_V(j_) do { const int k0_ = (j_) * 64; \
        _Pragma("unroll") for (int i = 0; i < 2; ++i) { const int c = tid + i * NTHR, row = c >> 3, cc = c & 7; pv_[i] = *(const u32x4*)(Vt + (size_t)row * SEQ + k0_ + cc * 8); } } while (0)
#define ATT_ISSUE(j_) do { ATT_ISSUE_K(j_); ATT_ISSUE_V(j_); } while (0)
    __syncthreads();
    ATT_ISSUE(0);
    for (int j = 0; j < ntiles; ++j) {
        unsigned char* st = smem + (j & 1) * STAGE;
        bf16_t* Ks = (bf16_t*)st; bf16_t* Vs = (bf16_t*)(st + 64 * KLD * 2); float* cks = (float*)(st + 64 * KLD * 2 + 128 * VLD * 2);
        if (amode != 5 || j == 0) {
#pragma unroll
        for (int i = 0; i < NKL; ++i) { const int c = tid + i * NTHR, row = c / NKC, cc = c % NKC; *(u32x4*)(Ks + row * KLD + cc * 8) = pk_[i]; }
#pragma unroll
        for (int i = 0; i < 2; ++i) { const int c = tid + i * NTHR, row = c >> 3, cc = c & 7; u32x2 lo, hi; lo[0] = pv_[i][0]; lo[1] = pv_[i][1]; hi[0] = pv_[i][2]; hi[1] = pv_[i][3];
            *(u32x2*)(Vs + row * VLD + cc * 8) = lo; *(u32x2*)(Vs + row * VLD + cc * 8 + 4) = hi; }
        if (DECAY && tid < 64) cks[tid] = pc_;
        }
        __syncthreads();
        const int k0 = j * 64;
        const bool active = (k0 <= q0 + 31) && (amode != 4);
        f32x16 sacc[2];
        if (active) {
#pragma unroll
            for (int kb = 0; kb < 2; ++kb) {
                constexpr int NB = KS / 4;
                const bf16_t* kp = Ks + (32 * kb + r) * KLD + 8 * h2;
                bf16x8 kf[2][4];
#pragma unroll
                for (int e = 0; e < 4; ++e) kf[0][e] = *(const bf16x8*)(kp + 16 * e);
                f32x16 acc; for (int i = 0; i < 16; ++i) acc[i] = 0.f;
#pragma unroll
                for (int bb = 0; bb < NB; ++bb) {
                    if (bb + 1 < NB) {
#pragma unroll
                        for (int e = 0; e < 4; ++e) kf[(bb + 1) & 1][e] = *(const bf16x8*)(kp + 16 * (4 * (bb + 1) + e)); }
                    __builtin_amdgcn_sched_barrier(0);
#pragma unroll
                    for (int e = 0; e < 4; ++e) acc = MFMA32(kf[bb & 1][e], qf[4 * bb + e], acc);
                    __builtin_amdgcn_sched_barrier(0);
                }
                sacc[kb] = acc;
            }
        }
        if (j + 1 < ntiles && amode != 5) ATT_ISSUE_K(j + 1);
        if (active) {
            const bool masked = (k0 + 63 > q0); const int qpos = q0 + r;
#pragma unroll
            for (int kb = 0; kb < 2; ++kb) {
                bf16x8 vfa[2][2], vfb[2][2];
#pragma unroll
                for (int d = 0; d < 2; ++d) { vfa[d][0] = ld_perm(Vs + (32 * d + r) * VLD + 32 * kb + 4 * h2); vfa[d][1] = ld_perm(Vs + (32 * d + r) * VLD + 32 * kb + 16 + 4 * h2); }
                f32x4 c4[2];
                if (DECAY) {
#pragma unroll
                    for (int g = 0; g < 2; ++g) c4[g] = *(const f32x4*)(cks + 32 * kb + 8 * g + 4 * h2); }
                __builtin_amdgcn_sched_barrier(0);
                if (DECAY) {
#pragma unroll
                    for (int g = 0; g < 2; ++g)
#pragma unroll
                        for (int e = 0; e < 4; ++e) sacc[kb][4 * g + e] -= c4[g][e];
#pragma unroll
                    for (int g = 0; g < 2; ++g) c4[g] = *(const f32x4*)(cks + 32 * kb + 8 * (g + 2) + 4 * h2);
#pragma unroll
                    for (int g = 0; g < 2; ++g)
#pragma unroll
                        for (int e = 0; e < 4; ++e) sacc[kb][4 * (g + 2) + e] -= c4[g][e];
                }
                if (masked) {
#pragma unroll
                    for (int i = 0; i < 16; ++i) { if (k0 + 32 * kb + crow(i, h2) > qpos) sacc[kb][i] = -INFINITY; } }
                float rs = 0.f;
#pragma unroll
                for (int i = 0; i < 16; ++i) { const float pz = __builtin_amdgcn_exp2f(sacc[kb][i] + c0); sacc[kb][i] = pz; rs += pz; }
                l_run += rs;
                const bf16x8 pf0 = pack8(sacc[kb], 0), pf1 = pack8(sacc[kb], 1);
                __builtin_amdgcn_sched_barrier(0);
#pragma unroll
                for (int d = 0; d < 2; ++d) { oacc[d] = MFMA32(vfa[d][0], pf0, oacc[d]); oacc[d] = MFMA32(vfa[d][1], pf1, oacc[d]); }
#pragma unroll
                for (int d = 0; d < 2; ++d) { vfb[d][0] = ld_perm(Vs + (32 * (d + 2) + r) * VLD + 32 * kb + 4 * h2); vfb[d][1] = ld_perm(Vs + (32 * (d + 2) + r) * VLD + 32 * kb + 16 + 4 * h2); }
                if (kb == 1 && j + 1 < ntiles && amode != 5) ATT_ISSUE_V(j + 1);
                __builtin_amdgcn_sched_barrier(0);
#pragma unroll
                for (int d = 0; d < 2; ++d) { oacc[d + 2] = MFMA32(vfb[d][0], pf0, oacc[d + 2]); oacc[d + 2] = MFMA32(vfb[d][1], pf1, oacc[d + 2]); }
            }
        } else if (j + 1 < ntiles && amode != 5) ATT_ISSUE_V(j + 1);
    }
#undef ATT_ISSUE
#undef ATT_ISSUE_K
#undef ATT_ISSUE_V
    l_run += __shfl_xor(l_run, 32);
    if (rep && l_run != 12345.678f) return;
    const float inv = __builtin_amdgcn_rcpf(l_run);
    bf16_t* op = O + (size_t)(q0 + r) * ldo;
#pragma unroll
    for (int d = 0; d < 4; ++d)
#pragma unroll
        for (int i4 = 0; i4 < 4; ++i4) { u32x2 o; o[0] = pk2(oacc[d][4 * i4] * inv, oacc[d][4 * i4 + 1] * inv); o[1] = pk2(oacc[d][4 * i4 + 2] * inv, oacc[d][4 * i4 + 3] * inv);
            *(u32x2*)(op + 32 * d + 8 * i4 + 4 * h2) = o; }
}

DI void sg_item(int item, const bf16_t* proj, const bf16_t* sgw, const float* vng, const float* bs, bf16_t* obuf, unsigned char* smem, const int tid) {
    const int lane = tid & 63, wv = tid >> 6, r = lane & 31, h2 = lane >> 5;
    const int g = item & 3, n = (item >> 2) & 31, b = item >> 7;
    const int t0 = b * SEQ + n * 128;
    bf16_t* vT = (bf16_t*)smem;
    const int tb = wv >> 1;
    const bf16_t* W = sgw + (size_t)g * 16384;
    bf16x8 wf[8];
#pragma unroll
    for (int ks = 0; ks < 8; ++ks) wf[ks] = *(const bf16x8*)(W + (32 * tb + r) * 128 + 16 * ks + 8 * h2);
    float va[16][2];
#pragma unroll
    for (int e = 0; e < 16; ++e) { const bf16_t* vr = proj + (size_t)(t0 + wv * 16 + e) * PLD + 3008 + g * 128; va[e][0] = bf2f(vr[lane]); va[e][1] = bf2f(vr[lane + 64]); }
    const float g0 = vng[g * 128 + lane], g1 = vng[g * 128 + lane + 64];
    __syncthreads();
    {
        float n0[16], n1[16];
#pragma unroll
        for (int e = 0; e < 16; ++e) { const float a0 = geluf_(va[e][0]), a1 = geluf_(va[e][1]);
            const float ss = wave_sum(a0 * a0 + a1 * a1); const float rs = rsqrtf(ss * (1.f / 128.f) + NEPS);
            n0[e] = a0 * rs * g0; n1[e] = a1 * rs * g1; }
        u32x4 o0, o1;
#pragma unroll
        for (int e = 0; e < 4; ++e) { o0[e] = pk2(n0[2 * e], n0[2 * e + 1]); o1[e] = pk2(n0[8 + 2 * e], n0[8 + 2 * e + 1]); }
        *(u32x4*)(vT + lane * 136 + wv * 16) = o0; *(u32x4*)(vT + lane * 136 + wv * 16 + 8) = o1;
#pragma unroll
        for (int e = 0; e < 4; ++e) { o0[e] = pk2(n1[2 * e], n1[2 * e + 1]); o1[e] = pk2(n1[8 + 2 * e], n1[8 + 2 * e + 1]); }
        *(u32x4*)(vT + (lane + 64) * 136 + wv * 16) = o0; *(u32x4*)(vT + (lane + 64) * 136 + wv * 16 + 8) = o1;
    }
    __syncthreads();
#pragma unroll
    for (int ci = 0; ci < 2; ++ci) { const int cb = 2 * (wv & 1) + ci; const int c = 32 * cb + r;
        float uv[16];
#pragma unroll
        for (int i = 0; i < 16; ++i) uv[i] = bf2f(proj[(size_t)(t0 + 32 * tb + crow(i, h2)) * PLD + 2496 + g * 128 + c]);
        f32x16 acc; for (int i = 0; i < 16; ++i) acc[i] = 0.f;
#pragma unroll
        for (int ks = 0; ks < 8; ++ks) if (ks < 2 * (tb + 1)) acc = MFMA32(wf[ks], *(const bf16x8*)(vT + (32 * cb + r) * 136 + 16 * ks + 8 * h2), acc);
#pragma unroll
        for (int i = 0; i < 16; ++i) { const int t = 32 * tb + crow(i, h2);
            obuf[(size_t)(t0 + t) * 2048 + 1024 + g * 128 + c] = f2bf(geluf_(uv[i]) * (acc[i] + bs[g * 128 + t])); } }
}

#define XB_TMO      128
#define XB_XCNT(j)  (256  + 64 * (j))
#define XB_XSUB(j)  (1280 + 64 * (j))
#define XB_XGEN(j)  (2304 + 64 * (j))
#define XB_TOP      3328
#define XB_TOPGEN   3392
#define XCD_BAR_WORDS 3456
#define XB_SPIN_CAP (1u << 18)

__device__ __forceinline__ unsigned xb_ld(unsigned* p)              { return __hip_atomic_load(p, __ATOMIC_RELAXED, __HIP_MEMORY_SCOPE_AGENT); }
__device__ __forceinline__ unsigned xb_add(unsigned* p, unsigned v) { return __hip_atomic_fetch_add(p, v, __ATOMIC_RELAXED, __HIP_MEMORY_SCOPE_AGENT); }
__device__ __forceinline__ unsigned xb_xcc_id() { return (unsigned)__builtin_amdgcn_s_getreg((3 << 11) | 20) & 0xFu; }
#define XB_SPIN(cond, bar) do { unsigned _sp = 0; while (cond) { __builtin_amdgcn_s_sleep(1); \
    if ((++_sp & 255u) == 0u) { if (xb_ld(&(bar)[XB_TMO])) break; if (_sp > XB_SPIN_CAP) { atomicAdd(&(bar)[XB_TMO], 1u); break; } } } } while (0)

struct XcdBarrier {
    unsigned* bar; unsigned x;
    volatile LAS unsigned* st;
};

__device__ __forceinline__ XcdBarrier xcd_barrier_post(unsigned* bar, volatile LAS unsigned* st) {
    XcdBarrier b; b.bar = bar; b.x = xb_xcc_id(); b.st = st;
    if (threadIdx.x == 0) (void)xb_add(&bar[XB_XCNT(b.x)], 1u);
    return b;
}
__device__ __forceinline__ void xcd_barrier_complete(unsigned* bar, unsigned x, unsigned& nloc, unsigned& nx) {
    const unsigned G = gridDim.x * gridDim.y * gridDim.z;
    unsigned sum, cnt, mine, sp = 0u;
    for (;;) {
        sum = 0u; cnt = 0u; mine = 0u;
#pragma unroll
        for (unsigned j = 0; j < 16; ++j) { const unsigned c = xb_ld(&bar[XB_XCNT(j)]); sum += c; cnt += (c > 0u) ? 1u : 0u; mine = (j == x) ? c : mine; }
        if (sum == G) break;
        __builtin_amdgcn_s_sleep(1);
        if ((++sp & 255u) == 0u) { if (xb_ld(&bar[XB_TMO])) break; if (sp > XB_SPIN_CAP) { atomicAdd(&bar[XB_TMO], 1u); break; } }
    }
    nloc = mine > 0u ? mine : 1u; nx = cnt > 0u ? cnt : 1u;
}

__device__ __forceinline__ void xcd_barrier(const XcdBarrier& b) {
    asm volatile("s_waitcnt vmcnt(0)" ::: "memory");
    __syncthreads();
    if (threadIdx.x == 0) {
        unsigned* bar = b.bar;
        __builtin_amdgcn_s_waitcnt(0);
        unsigned nloc = b.st[0], nx = b.st[1];
        if (nloc == 0u) { xcd_barrier_complete(bar, b.x, nloc, nx); b.st[0] = nloc; b.st[1] = nx; }
        const unsigned old = xb_add(&bar[XB_XSUB(b.x)], 1u);
        const unsigned gen = old / nloc;
        if (old + 1u == (gen + 1u) * nloc) {
            __builtin_amdgcn_fence(__ATOMIC_RELEASE, "agent");
            asm volatile("s_waitcnt vmcnt(0)" ::: "memory");
            const unsigned og = xb_add(&bar[XB_TOP], 1u);
            const unsigned tg = og / nx;
            if (og + 1u == (tg + 1u) * nx) xb_add(&bar[XB_TOPGEN], 1u);
            else XB_SPIN(xb_ld(&bar[XB_TOPGEN]) == tg, bar);
            __builtin_amdgcn_fence(__ATOMIC_ACQUIRE, "agent");
            xb_add(&bar[XB_XGEN(b.x)], 1u);
            asm volatile("s_waitcnt vmcnt(0)" ::: "memory");
        } else {
            XB_SPIN(xb_ld(&bar[XB_XGEN(b.x)]) == gen, bar);
            __builtin_amdgcn_fence(__ATOMIC_ACQUIRE, "agent");
            asm volatile("s_waitcnt vmcnt(0)" ::: "memory");
        }
    }
    __syncthreads();
}

#define PIN(k) (p.in[k])
#define POUT (p.out)
DI void run_phase(const Params& p, int ph, unsigned char* smem, const int tid, const int rep) {
    const int l = ph / N_STEPS, s = ph % N_STEPS;
    const int lane = tid & 63, wv = tid >> 6;
    unsigned char* ws = p.ws;
    bf16_t* wt_in = (bf16_t*)(ws + OFF_WT_IN); bf16_t* wt_gate = (bf16_t*)(ws + OFF_WT_GATE); bf16_t* wt_mla = (bf16_t*)(ws + OFF_WT_MLA); bf16_t* wt_br = (bf16_t*)(ws + OFF_WT_BR);
    bf16_t* wt_out = (bf16_t*)(ws + OFF_WT_OUT); bf16_t* wt_ff1 = (bf16_t*)(ws + OFF_WT_FF1); bf16_t* wt_ff2 = (bf16_t*)(ws + OFF_WT_FF2); bf16_t* sgw = (bf16_t*)(ws + OFF_SGW);
    bf16_t* hbuf = (bf16_t*)(ws + OFF_HBUF); bf16_t* proj = (bf16_t*)(ws + OFF_PROJ); float* small = (float*)(ws + OFF_SMALL);
    bf16_t* mlaa = (bf16_t*)(ws + OFF_MLAA); bf16_t* mlaraw = (bf16_t*)(ws + OFF_MLARAW); bf16_t* mlaq = (bf16_t*)(ws + OFF_MLAQ); bf16_t* mlak = (bf16_t*)(ws + OFF_MLAK);
    bf16_t* mlavt = (bf16_t*)(ws + OFF_MLAVT); bf16_t* foxvt = (bf16_t*)(ws + OFF_FOXVT); float* foxcum = (float*)(ws + OFF_FOXCUM);
    bf16_t* obuf = (bf16_t*)(ws + OFF_OBUF); bf16_t* Pb = (bf16_t*)(ws + OFF_P); bf16_t* merged = (bf16_t*)(ws + OFF_MERGED); bf16_t* hid = (bf16_t*)(ws + OFF_HID);
    unsigned* ctr = (unsigned*)ws;
    LAS unsigned char* lds = (LAS unsigned char*)smem;
    const float* xsrc = (l == 0) ? PIN(0) : POUT;

    if (s == 0) {
        float* tl = (float*)smem;
        { const float* w = PIN(3) + (size_t)l * 1024 * 9164;
          convert_mat(wt_in, 5120, 1024, [&](int n, int k) -> float { int sc; if (n < 2048) sc = n; else if (n < 5056) sc = n + 8; else if (n < 5064) sc = n - 5056 + 2048; else if (n < 5068) sc = n; else sc = -1;
              const float vv = w[(size_t)k * 9164 + (sc >= 0 ? sc : 0)]; return sc >= 0 ? vv : 0.f; }, tl, tid);
          convert_mat(wt_gate, 4096, 1024, [&](int n, int k) -> float { const int pn = n >> 8, c = n & 255, bj = c >> 7, wc = (c >> 5) & 3, nn = (c >> 4) & 1, fq = (c >> 2) & 3, j = c & 3;
              const int d = 64 * pn + 16 * wc + 4 * fq + 2 * bj + nn; return -LOG2E * w[(size_t)k * 9164 + 5068 + j * 1024 + d]; }, tl, tid); }
        { const float* wq = PIN(10) + (size_t)l * 256 * 768; const float* wkv = PIN(11) + (size_t)l * 128 * 1024;
          convert_mat(wt_mla, 1792, 256, [&](int n, int k) -> float { const bool isq = n < 768; const bool ok = isq || (k >= 128); const float* bp = isq ? wq : wkv; const size_t off = ok ? (isq ? (size_t)k * 768 + n : (size_t)(k - 128) * 1024 + (n - 768)) : 0; const float vv = bp[off]; return ok ? vv : 0.f; }, tl, tid); }
        { const float* w = PIN(20) + (size_t)l * 4 * 512 * 1024; convert_mat(wt_br, 4096, 512, [&](int n, int k) -> float { return w[((size_t)(n >> 10) * 512 + k) * 1024 + (n & 1023)]; }, tl, tid); }
        { const float* w = PIN(21) + (size_t)l * 1024 * 1024; convert_mat(wt_out, 1024, 1024, [&](int n, int k) -> float { return w[(size_t)k * 1024 + n]; }, tl, tid); }
        { const float* w = PIN(23) + (size_t)l * 1024 * 4096; convert_mat(wt_ff1, 4096, 1024, [&](int n, int k) -> float { return w[(size_t)k * 4096 + n]; }, tl, tid); }
        { const float* w = PIN(24) + (size_t)l * 4096 * 1024; convert_mat(wt_ff2, 1024, 4096, [&](int n, int k) -> float { return w[(size_t)k * 1024 + n]; }, tl, tid); }
        { const float* w = PIN(15) + (size_t)l * 4 * 128 * 128;
          for (int i = blockIdx.x * NTHR + tid; i < 4 * 128 * 128; i += gridDim.x * NTHR) { const int t = (i >> 7) & 127, sx = i & 127; const float vv = w[i]; sgw[i] = f2bf(sx <= t ? vv : 0.f); } }
        rmsnorm_phase(xsrc, PIN(2) + l * 1024, hbuf, 65536, tid);
        return;
    }
    if (s == 17) { rmsnorm_phase(POUT, PIN(22) + l * 1024, hbuf, 65536, tid); return; }
    if (s == 18) { pg8::Gemm g{hbuf, wt_ff1, 1024, 1024, 1024, 256, 16, 1, 0, 0, 1 << 30, 0}; pg8::EpiBf16<1> E{hid, 4096, 0}; pg8::gemm_phase(lds, g, E, tid); return; }
    if (s == 19) { pg8::Gemm g{hid, wt_ff2, 4096, 4096, 4096, 256, 4, 1, 0, 0, 1 << 30, 0}; pg8::EpiResid E{POUT, POUT}; pg8::gemm_phase(lds, g, E, tid); return; }

    const int hb = (s - 1) / 8, st = (s - 1) % 8 + 1;
    const size_t tok0 = (size_t)hb * TS;
    switch (st) {
    case 1: { pg8::Gemm g{hbuf + tok0 * 1024, wt_in, 1024, 1024, 1024, 128, 20, 1, 0, 0, 1 << 30, 0}; pg8::EpiProj E{proj, small}; pg8::gemm_phase(lds, g, E, tid); } break;
    case 2: {
        if (rep == 0) { const float* gq = PIN(8) + l * 256; const float* gkv = PIN(9) + l * 128; const float* fqg = PIN(17) + l * 128; const float* fkg = PIN(18) + l * 128;
          const f32x4 ggq = *(const f32x4*)(gq + 4 * lane); const float gkv0 = gkv[2 * lane], gkv1 = gkv[2 * lane + 1];
          const float fq0 = fqg[2 * lane], fq1 = fqg[2 * lane + 1], fk0 = fkg[2 * lane], fk1 = fkg[2 * lane + 1];
          for (int t0 = (blockIdx.x * 8 + wv) * 4; t0 < TS; t0 += gridDim.x * 32) {
              u32x2 vq[4]; unsigned vkv[4], vf[4][8];
#pragma unroll
              for (int u = 0; u < 4; ++u) { const bf16_t* pr = proj + (size_t)(t0 + u) * PLD; vq[u] = *(const u32x2*)(pr + 2048 + 4 * lane); vkv[u] = *(const unsigned*)(pr + 2304 + 2 * lane);
#pragma unroll
                  for (int hq = 0; hq < 8; ++hq) vf[u][hq] = *(const unsigned*)(pr + 3520 + hq * 128 + 2 * lane); }
#pragma unroll
              for (int u = 0; u < 4; ++u) { const int t = t0 + u; bf16_t* pr = proj + (size_t)t * PLD;
                  { const u32x2 v = vq[u]; const float a0 = __uint_as_float(v[0] << 16), a1 = __uint_as_float(v[0] & 0xffff0000u), a2 = __uint_as_float(v[1] << 16), a3 = __uint_as_float(v[1] & 0xffff0000u);
                    const float rs = rsqrtf(wave_sum(a0 * a0 + a1 * a1 + a2 * a2 + a3 * a3) * (1.f / 256.f) + NEPS);
                    u32x2 o; o[0] = pk2(a0 * rs * ggq[0], a1 * rs * ggq[1]); o[1] = pk2(a2 * rs * ggq[2], a3 * rs * ggq[3]); *(u32x2*)(mlaa + (size_t)t * 384 + 4 * lane) = o; }
                  { const unsigned v = vkv[u]; const float a0 = __uint_as_float(v << 16), a1 = __uint_as_float(v & 0xffff0000u);
                    const float rs = rsqrtf(wave_sum(a0 * a0 + a1 * a1) * (1.f / 128.f) + NEPS);
                    *(unsigned*)(mlaa + (size_t)t * 384 + 256 + 2 * lane) = pk2(a0 * rs * gkv0, a1 * rs * gkv1); }
#pragma unroll
                  for (int hq = 0; hq < 8; ++hq) { const unsigned v = vf[u][hq]; const float a0 = __uint_as_float(v << 16), a1 = __uint_as_float(v & 0xffff0000u);
                    const float rs = rsqrtf(wave_sum(a0 * a0 + a1 * a1) * (1.f / 128.f) + NEPS) * ((hq < 4) ? 0.08838834764831845f * LOG2E : 1.f);
                    *(unsigned*)(pr + 3520 + hq * 128 + 2 * lane) = pk2(a0 * rs * ((hq < 4) ? fq0 : fk0), a1 * rs * ((hq < 4) ? fq1 : fk1)); } } } }
        if (blockIdx.x < 32 && (rep == 0 || PROBE_SUB == 1)) { const int b = blockIdx.x >> 2, h = blockIdx.x & 3; const float fb = PIN(19)[l * 4 + h]; float* red = (float*)smem;
            float lf[8]; float tot = 0.f;
#pragma unroll
            for (int e = 0; e < 8; ++e) { const float x = small[(size_t)(b * SEQ + tid * 8 + e) * 16 + 8 + h] + fb; lf[e] = fminf(x, 0.f) - log1pf(__expf(-fabsf(x))); tot += lf[e]; }
            float inc = tot; for (int o = 1; o < 64; o <<= 1) { const float t = __shfl_up(inc, o); if (lane >= o) inc += t; }
            __syncthreads();
            if (lane == 63) red[wv] = inc;
            __syncthreads();
            float base = inc - tot; for (int w = 0; w < wv; ++w) base += red[w];
            f32x4 o0, o1; float run = base;
#pragma unroll
            for (int e = 0; e < 4; ++e) { run += lf[e]; o0[e] = run; }
#pragma unroll
            for (int e = 0; e < 4; ++e) { run += lf[4 + e]; o1[e] = run; }
            float* dp = foxcum + (size_t)(b * 4 + h) * SEQ + tid * 8; *(f32x4*)dp = o0; *(f32x4*)(dp + 4) = o1;
            __syncthreads(); }
        if (rep == 0 || PROBE_SUB == 2) transpose_v_phase(proj, PLD, 3520 + 1024, 128, foxvt, (bf16_t*)smem, tid);
        { DnPrepArgs a{proj, small, PIN(4) + (size_t)l * 4 * 1536, PIN(5) + l * 4, PIN(6) + l * 4,
                       (bf16_t*)(ws + OFF_DN_QDEC), (bf16_t*)(ws + OFF_DN_NEGW), (bf16_t*)(ws + OFF_DN_U), (bf16_t*)(ws + OFF_DN_KDT), (bf16_t*)(ws + OFF_DN_AQK), (float*)(ws + OFF_DN_GLAST)};
          if (rep == 0 || PROBE_SUB == 3) for (int it = blockIdx.x; it < NCH; it += gridDim.x) { int tq = tid; asm volatile("" : "+v"(tq)); dn_prep_item(it, a, smem, tq, rep ? PROBE_LIM : 9); } }
    } break;
    case 3: { pg8::Gemm g{mlaa, wt_mla, 384, 256, 256, 128, 7, 1, 0, 0, 3, 128}; pg8::EpiBf16<0> E{mlaraw, 1792, 0}; pg8::gemm_phase(lds, g, E, tid); } break;
    case 4: {
        const float* gqq = PIN(12) + l * 192; const float* gkk = PIN(13) + l * 192; const int* pos = (const int*)PIN(1);
        const int fi = lane & 31; const float invf = powf(10000.f, -(float)(2 * fi) / 64.f);
        const float gq0 = gqq[lane], gq1 = gqq[lane + 64], gq2 = gqq[lane + 128], gk0 = gkk[lane], gk1 = gkk[lane + 64], gk2 = gkk[lane + 128];
        for (int t0 = (blockIdx.x * 8 + wv) * 2; t0 < TS; t0 += gridDim.x * 16) {
            float krv[2], qa[2][4][3], ka[2][4][2]; int ps[2];
#pragma unroll
            for (int u = 0; u < 2; ++u) { const int t = t0 + u; ps[u] = pos[tok0 + t]; krv[u] = bf2f(proj[(size_t)t * PLD + 2432 + lane]);
#pragma unroll
                for (int h = 0; h < 4; ++h) { const bf16_t* qr = mlaraw + (size_t)t * 1792 + h * 192; const bf16_t* kp = mlaraw + (size_t)t * 1792 + 768 + h * 256;
                    qa[u][h][0] = bf2f(qr[lane]); qa[u][h][1] = bf2f(qr[lane + 64]); qa[u][h][2] = bf2f(qr[lane + 128]); ka[u][h][0] = bf2f(kp[lane]); ka[u][h][1] = bf2f(kp[lane + 64]); } }
#pragma unroll
            for (int u = 0; u < 2; ++u) { const int t = t0 + u;
                const float ang = (float)ps[u] * invf; float sn, cs; sincosf(ang, &sn, &cs);
                const float kr = krv[u];
#pragma unroll
                for (int h = 0; h < 4; ++h) {
                    { const float a0 = qa[u][h][0], a1 = qa[u][h][1], a2 = qa[u][h][2];
                      const float rs = rsqrtf(wave_sum(a0 * a0 + a1 * a1 + a2 * a2) * (1.f / 192.f) + NEPS) * (0.07216878364870322f * LOG2E);
                      const float y2 = a2 * rs * gq2; const float oth = __shfl_xor(y2, 32);
                      const float rot = (lane < 32) ? (y2 * cs - oth * sn) : (y2 * cs + oth * sn);
                      bf16_t* qo = mlaq + (size_t)t * 768 + h * 192; qo[lane] = f2bf(a0 * rs * gq0); qo[lane + 64] = f2bf(a1 * rs * gq1); qo[lane + 128] = f2bf(rot); }
                    { const float a0 = ka[u][h][0], a1 = ka[u][h][1];
                      const float rs = rsqrtf(wave_sum(a0 * a0 + a1 * a1 + kr * kr) * (1.f / 192.f) + NEPS);
                      const float y2 = kr * rs * gk2; const float oth = __shfl_xor(y2, 32);
                      const float rot = (lane < 32) ? (y2 * cs - oth * sn) : (y2 * cs + oth * sn);
                      bf16_t* ko = mlak + (size_t)t * 768 + h * 192; ko[lane] = f2bf(a0 * rs * gk0); ko[lane + 64] = f2bf(a1 * rs * gk1); ko[lane + 128] = f2bf(rot); }
                }
            }
        }
        transpose_v_phase(mlaraw, 1792, 768 + 128, 256, mlavt, (bf16_t*)smem, tid);
    } break;
    case 5: {
        DnScanArgs da{(bf16_t*)(ws + OFF_DN_QDEC), (bf16_t*)(ws + OFF_DN_NEGW), (bf16_t*)(ws + OFF_DN_U), (bf16_t*)(ws + OFF_DN_KDT), (bf16_t*)(ws + OFF_DN_AQK), (float*)(ws + OFF_DN_GLAST), obuf, proj, PIN(7) + l * 128};
        int* s_item = (int*)(smem + LDS_BYTES - 64);
        { const float* g1 = PIN(12) + l * 192; const float* g2 = PIN(13) + l * 192; const float* g3 = PIN(17) + l * 128; const float* g4 = PIN(18) + l * 128;
          float a1 = fmaxf(fmaxf(fabsf(g1[lane]), fabsf(g1[lane + 64])), fabsf(g1[lane + 128])), a2 = fmaxf(fmaxf(fabsf(g2[lane]), fabsf(g2[lane + 64])), fabsf(g2[lane + 128]));
          float a3 = fmaxf(fabsf(g3[lane]), fabsf(g3[lane + 64])), a4 = fmaxf(fabsf(g4[lane]), fabsf(g4[lane + 64]));
          for (int o = 32; o; o >>= 1) { a1 = fmaxf(a1, __shfl_xor(a1, o)); a2 = fmaxf(a2, __shfl_xor(a2, o)); a3 = fmaxf(a3, __shfl_xor(a3, o)); a4 = fmaxf(a4, __shfl_xor(a4, o)); }
          if (tid == 0) { float* mp = (float*)(smem + LDS_BYTES - 48); mp[0] = a1 * a2 * 13.856406460551018f * LOG2E; mp[1] = a3 * a4 * 11.313708498984761f * LOG2E; } }
        if (tid == 0) s_item[1] = 0;
        for (;;) {
            __syncthreads();
            if (tid == 0) { int qi = s_item[1]; const int xcc = (int)(xb_xcc_id() & 7u); int v = -1;
                for (; qi < 8; ++qi) { const int xq = (xcc + qi) & 7; const int li = (int)atomicAdd(ctr + 128 + ph * 8 + xq, 1u); if (li < 4 + 128 + 128) { v = (xq << 16) | li; break; } }
                s_item[1] = qi; s_item[0] = v; }
            __syncthreads();
            const int v = *s_item;
            if (v < 0) break;
            const int xq = v >> 16, li = v & 0xffff;
            int tq = tid; asm volatile("" : "+v"(tq));
            if (li < 4) dn_scan_item(xq * 4 + li, da, smem, tq);
            else if (li < 4 + 128) { const int idx = li - 4, qt = 15 - (idx >> 3), rr = xq * 8 + (idx & 7), type = rr & 1, bh = rr >> 1, b = bh >> 2, h = bh & 3;
                if (type == 0) attn_item<192, false>(mlaq + (size_t)b * SEQ * 768 + h * 192, 768, mlak + (size_t)b * SEQ * 768 + h * 192, 768, mlavt + (size_t)bh * 128 * SEQ, nullptr,
                                                     obuf + (size_t)b * SEQ * 2048 + 512 + h * 128, 2048, qt, ((const float*)(smem + LDS_BYTES - 48))[0], smem, tq, rep);
                else attn_item<128, true>(proj + (size_t)b * SEQ * PLD + 3520 + h * 128, PLD, proj + (size_t)b * SEQ * PLD + 3520 + 512 + h * 128, PLD, foxvt + (size_t)bh * 128 * SEQ, foxcum + (size_t)bh * SEQ,
                                          obuf + (size_t)b * SEQ * 2048 + 1536 + h * 128, 2048, qt, ((const float*)(smem + LDS_BYTES - 48))[1], smem, tq, rep); }
            else sg_item(xq * 128 + (li - 132), proj, sgw, PIN(14) + l * 512, PIN(16) + l * 512, obuf, smem, tq);
        }
    } break;
    case 6: { pg8::Gemm g{obuf, wt_br, 2048, 512, 512, 128, 4, 4, 512, (long)1024 * 512, 1 << 30, 0}; pg8::EpiBf16<0> E{Pb, 4096, 1024}; pg8::gemm_phase(lds, g, E, tid); } break;
    case 7: { pg8::Gemm g{hbuf + tok0 * 1024, wt_gate, 1024, 1024, 1024, 128, 16, 1, 0, 0, 1 << 30, 0}; pg8::EpiMerge E{Pb, merged}; pg8::gemm_phase(lds, g, E, tid); } break;
    case 8: { pg8::Gemm g{merged, wt_out, 1024, 1024, 1024, 128, 4, 1, 0, 0, 1 << 30, 0}; pg8::EpiResid E{POUT + tok0 * 1024, xsrc + tok0 * 1024}; pg8::gemm_phase(lds, g, E, tid); } break;
    }
}

__global__ void __launch_bounds__(512, 2) mega(Params p) {
    extern __shared__ __attribute__((aligned(16))) unsigned char smem[];
    cg::grid_group grid = cg::this_grid();
    volatile LAS unsigned* bst = (volatile LAS unsigned*)(LAS unsigned char*)(smem + LDS_BYTES - 32);
    if (threadIdx.x == 0) { bst[0] = 0u; bst[1] = 0u; }
    __syncthreads();
    XcdBarrier xb; xb.bar = (unsigned*)(p.ws + 4096); xb.x = 0; xb.st = bst;
    const bool multi = (p.ph_hi - p.ph_lo) > 1;
    if (multi) xb = xcd_barrier_post((unsigned*)(p.ws + 4096), bst);
    for (int ph = p.ph_lo; ph < p.ph_hi; ++ph) {
        if (ph == p.ph_lo + 1) grid.sync();
        else if (ph > p.ph_lo) xcd_barrier(xb);
#if PROBE_SYNCS
        for (int e = 0; e < PROBE_SYNCS; ++e) xcd_barrier(xb);
#endif
        int tid = threadIdx.x; asm volatile("" : "+v"(tid));
        run_phase(p, ph, smem, tid, 0);
#if PROBE_ST == 2
        { const int s_ = ph % N_STEPS; const int st_ = (s_ >= 1 && s_ <= 16) ? (s_ - 1) % 8 + 1 : (s_ == 0 ? 0 : s_);
          if (st_ == 2) { xcd_barrier(xb); const int l_ = ph / N_STEPS; unsigned char* ws = p.ws;
              DnPrepArgs a{(bf16_t*)(ws + OFF_PROJ), (float*)(ws + OFF_SMALL), p.in[4] + (size_t)l_ * 4 * 1536, p.in[5] + l_ * 4, p.in[6] + l_ * 4,
                           (bf16_t*)(ws + OFF_DN_QDEC), (bf16_t*)(ws + OFF_DN_NEGW), (bf16_t*)(ws + OFF_DN_U), (bf16_t*)(ws + OFF_DN_KDT), (bf16_t*)(ws + OFF_DN_AQK), (float*)(ws + OFF_DN_GLAST)};
              for (int it = blockIdx.x; it < NCH; it += gridDim.x) { int tq = threadIdx.x; asm volatile("" : "+v"(tq)); dn_prep_item(it, a, smem, tq, PROBE_LIM); } } }
#elif PROBE_ST >= 0
        { const int s_ = ph % N_STEPS; const int st_ = (s_ >= 1 && s_ <= 16) ? (s_ - 1) % 8 + 1 : (s_ == 0 ? 0 : s_);
          if (st_ == PROBE_ST) { xcd_barrier(xb); int t2 = threadIdx.x; asm volatile("" : "+v"(t2)); run_phase(p, ph, smem, t2, 1); } }
#endif
    }
}

#ifndef N_LAUNCH_MODE
#define N_LAUNCH_MODE 1
#endif

extern "C" void kernel_launch(void* const* d_in, const int* in_sizes, int n_in, void* d_out, int out_size, void* d_ws, size_t ws_size, hipStream_t stream) {
    static int grid = 0;
    if (grid == 0) {
        if (n_in != 25 || ws_size < OFF_END) { fprintf(stderr, "kernel_launch: unexpected n_in %d or workspace %zu < %zu\n", n_in, ws_size, (size_t)OFF_END); grid = -1; return; }
        int dev = 0, cus = 0, per_cu = 0;
        hipGetDevice(&dev); hipDeviceGetAttribute(&cus, hipDeviceAttributeMultiprocessorCount, dev);
        if (hipFuncSetAttribute((const void*)mega, hipFuncAttributeMaxDynamicSharedMemorySize, LDS_BYTES) != hipSuccess) { fprintf(stderr, "kernel_launch: hipFuncSetAttribute failed\n"); grid = -1; return; }
        if (hipOccupancyMaxActiveBlocksPerMultiprocessor(&per_cu, (const void*)mega, NTHR, LDS_BYTES) != hipSuccess || per_cu < 1) { fprintf(stderr, "kernel_launch: occupancy query gave %d\n", per_cu); per_cu = 1; }
        (void)hipGetLastError();
        grid = cus * per_cu;
    }
    if (grid < 0) return;
    hipMemsetAsync(d_ws, 0, SZ_CTL, stream);
    Params p{};
    for (int i = 0; i < 25; ++i) p.in[i] = (const float*)d_in[i];
    p.out = (float*)d_out; p.ws = (unsigned char*)d_ws;
#if N_LAUNCH_MODE == 1
    p.ph_lo = 0; p.ph_hi = N_PHASES;
    void* args[] = {&p};
    hipError_t e = hipLaunchCooperativeKernel((const void*)mega, dim3(grid), dim3(NTHR), args, LDS_BYTES, stream);
    if (e != hipSuccess) fprintf(stderr, "cooperative launch failed: %s (grid %d)\n", hipGetErrorString(e), grid);
#else
    for (int ph = 0; ph < N_PHASES; ++ph) { p.ph_lo = ph; p.ph_hi = ph + 1; hipLaunchKernelGGL(mega, dim3(grid), dim3(NTHR), LDS_BYTES, stream, p); }
#endif
}
```
